# Optimizing an MI355X kernel written in HIP

```python
import math
import jax, jax.numpy as jnp
from jax import lax
import numpy as np

D_MODEL = 1024
BATCH = 4
SEQ = 8192
DEPTH = 1

GRID_W = 64
CTX_LEN = 256
N_HEADS = 8
N_KV_HEADS = 2
HEAD_DIM = 128
Q_GROUP = N_HEADS // N_KV_HEADS
ATTN_WIDTH = N_HEADS * HEAD_DIM
KV_WIDTH = N_KV_HEADS * HEAD_DIM
ROPE_AXIS_DIM = HEAD_DIM // 2
ROPE_THETA = 10000.0
Q_BLOCK = 128
D_HYENA = D_MODEL // 2
HYENA_ORDER = 2
FILTER_EMB_DIM = 33
FILTER_HIDDEN = 64
FILTER_INNER = 2
DECAY_TARGET = 1e-2
FAST_DECAY_PCT = 0.3
SLOW_DECAY_PCT = 1.5
N_BRANCHES = 2
D_FF = 2816
CONV_W = 3
RMS_EPS = 1e-6
PROJ_WIDTH = ATTN_WIDTH + 2 * KV_WIDTH + (HYENA_ORDER + 1) * D_HYENA + N_BRANCHES * D_MODEL
N_MOD = 6

kernel_name = 'hybrid_gqa_hyena_convffn_prefix_dit'


def rmsnorm(x, w):
    xf = x.astype(jnp.float32)
    y = xf * lax.rsqrt(jnp.mean(xf * xf, axis=-1, keepdims=True) + RMS_EPS)
    return (y * w.astype(jnp.float32)).astype(x.dtype)


def modulation(cvec, w_mod, b_mod):
    m = jax.nn.silu(cvec) @ w_mod + b_mod
    return jnp.split(m[:, None, :], N_MOD, axis=-1)


def modulate(x, w, shift, scale):
    return rmsnorm(x, w) * (1.0 + scale) + shift


def dwconv3(u, w, b):
    up = jnp.pad(u, ((0, 0), (1, 1), (0, 0)))
    return up[:, :-2] * w[0] + up[:, 1:-1] * w[1] + up[:, 2:] * w[2] + b


def axial_rope_tables(L):
    rows = L // GRID_W
    row = jnp.repeat(jnp.arange(rows), GRID_W).astype(jnp.float32)
    col = jnp.tile(jnp.arange(GRID_W), rows).astype(jnp.float32)
    freqs = ROPE_THETA ** (-jnp.arange(0, ROPE_AXIS_DIM, 2, dtype=jnp.float32) / ROPE_AXIS_DIM)
    ang = jnp.concatenate([row[:, None] * freqs, col[:, None] * freqs], axis=-1)
    return jnp.cos(ang), jnp.sin(ang)


def apply_rope(x, cos, sin):
    xr = x.reshape(x.shape[:-1] + (HEAD_DIM // 2, 2))
    x1, x2 = xr[..., 0], xr[..., 1]
    cs = cos[None, :, None, :].astype(x.dtype)
    sn = sin[None, :, None, :].astype(x.dtype)
    return jnp.stack([x1 * cs - x2 * sn, x1 * sn + x2 * cs], axis=-1).reshape(x.shape)


def split_proj(p):
    B, L = p.shape[:2]
    q, k, v, hy, gates = jnp.split(
        p, [ATTN_WIDTH, ATTN_WIDTH + KV_WIDTH, ATTN_WIDTH + 2 * KV_WIDTH,
            ATTN_WIDTH + 2 * KV_WIDTH + (HYENA_ORDER + 1) * D_HYENA], axis=-1)
    q = q.reshape(B, L, N_HEADS, HEAD_DIM)
    k = k.reshape(B, L, N_KV_HEADS, HEAD_DIM)
    v = v.reshape(B, L, N_KV_HEADS, HEAD_DIM)
    return q, k, v, hy, gates


def attend(q, k_all, v_all):
    B, Lq = q.shape[:2]
    nblk = Lq // Q_BLOCK
    qb = q.reshape(B, nblk, Q_BLOCK, N_KV_HEADS, Q_GROUP, HEAD_DIM).transpose(1, 0, 2, 3, 4, 5)
    scale = HEAD_DIM ** -0.5

    def one_block(qi):
        s = jnp.einsum('bqhgd,bkhd->bhgqk', qi, k_all, preferred_element_type=jnp.float32) * scale
        p = jax.nn.softmax(s, axis=-1).astype(v_all.dtype)
        return jnp.einsum('bhgqk,bkhd->bqhgd', p, v_all)

    o = lax.map(one_block, qb)
    return o.transpose(1, 0, 2, 3, 4, 5).reshape(B, Lq, ATTN_WIDTH)


def hyena_filters(L, w1, b1, w_inner, b_inner, freq, w_out):
    t_idx = jnp.arange(L, dtype=jnp.float32)
    t = t_idx / max(L - 1, 1)
    bands = (FILTER_EMB_DIM - 1) // 2
    f = jnp.linspace(1e-4, bands - 1, bands, dtype=jnp.float32)
    wpos = 2.0 * math.pi * t_idx / L
    z = jnp.concatenate([t[:, None], jnp.cos(wpos[:, None] * f), -jnp.sin(wpos[:, None] * f)], axis=-1)
    h = jnp.sin(freq * (z @ w1 + b1))
    for j in range(FILTER_INNER):
        h = jnp.sin(freq * (h @ w_inner[j] + b_inner[j]))
    h = h @ w_out
    min_decay = math.log(DECAY_TARGET) / SLOW_DECAY_PCT
    max_decay = math.log(DECAY_TARGET) / FAST_DECAY_PCT
    deltas = jnp.linspace(min_decay, max_decay, D_HYENA, dtype=jnp.float32)
    decay = jnp.exp(-t[:, None] * jnp.abs(deltas))
    h = (h.reshape(L, 2, HYENA_ORDER, D_HYENA) * decay[:, None, None, :]).astype(jnp.float32)
    h_fwd, h_bwd = h[:, 0], h[:, 1]
    k = jnp.concatenate([h_fwd[:1] + h_bwd[:1], h_fwd[1:],
                         jnp.zeros((1, HYENA_ORDER, D_HYENA), jnp.float32), h_bwd[:0:-1]], axis=0)
    return jnp.fft.rfft(k, axis=0)


def fft_long_conv(u, K):
    L = u.shape[1]
    U = jnp.fft.rfft(u.astype(jnp.float32), n=2 * L, axis=1)
    y = jnp.fft.irfft(U * K[None], n=2 * L, axis=1)[:, :L]
    return y.astype(u.dtype)


def hyena(streams, conv_w, conv_b, w1, b1, w_inner, b_inner, freq, w_out, skip):
    L = streams.shape[1]
    u = dwconv3(streams, conv_w, conv_b)
    x1, x2, v = jnp.split(u, HYENA_ORDER + 1, axis=-1)
    K = hyena_filters(L, w1, b1, w_inner, b_inner, freq, w_out)
    z = v
    for o, gate in enumerate((x1, x2)):
        z = gate * (fft_long_conv(z, K[:, o]) + skip[o] * z)
    return z


def merge(attn_o, hy_o, gates, w_attn_out, w_hy_out, w_o, b_o):
    g_attn, g_hy = jnp.split(gates, N_BRANCHES, axis=-1)
    mixed = jax.nn.sigmoid(g_attn) * (attn_o @ w_attn_out) + jax.nn.sigmoid(g_hy) * (hy_o @ w_hy_out)
    return mixed @ w_o + b_o


def conv_ffn(h, w_up, b_up, conv_w, conv_b, w_down, b_down):
    u = dwconv3(h @ w_up + b_up, conv_w, conv_b)
    a, g = jnp.split(u, 2, axis=-1)
    return (jax.nn.gelu(a) * g) @ w_down + b_down


def setup_inputs(seed: int = 0) -> dict:
    key = jax.random.key(seed)
    ks = jax.random.split(key, 32)

    def nrm(k, shape, scale):
        return jax.random.normal(k, shape, jnp.float32) * scale

    def gain(k, shape):
        return 1.0 + nrm(k, shape, 0.02)

    L = DEPTH
    return {
        'x': nrm(ks[0], (BATCH, SEQ, D_MODEL), 1.0),
        'c': nrm(ks[1], (BATCH, D_MODEL), 1.0),
        'ctx': nrm(ks[2], (BATCH, CTX_LEN, D_MODEL), 1.0),
        'c_ctx': nrm(ks[3], (D_MODEL,), 1.0),
        'w_mod': nrm(ks[4], (L, D_MODEL, N_MOD * D_MODEL), 0.5 * D_MODEL ** -0.5),
        'b_mod': nrm(ks[5], (L, N_MOD * D_MODEL), 0.02),
        'norm1_w': gain(ks[6], (L, D_MODEL)),
        'norm2_w': gain(ks[7], (L, D_MODEL)),
        'w_in': nrm(ks[8], (L, D_MODEL, PROJ_WIDTH), D_MODEL ** -0.5),
        'b_in': nrm(ks[9], (L, PROJ_WIDTH), 0.02),
        'q_norm_w': gain(ks[10], (L, HEAD_DIM)),
        'k_norm_w': gain(ks[11], (L, HEAD_DIM)),
        'hy_conv_w': nrm(ks[12], (L, CONV_W, (HYENA_ORDER + 1) * D_HYENA), CONV_W ** -0.5),
        'hy_conv_b': nrm(ks[13], (L, (HYENA_ORDER + 1) * D_HYENA), 0.02),
        'filt_w1': nrm(ks[14], (L, FILTER_EMB_DIM, FILTER_HIDDEN), FILTER_EMB_DIM ** -0.5),
        'filt_b1': nrm(ks[15], (L, FILTER_HIDDEN), 0.02),
        'filt_w_inner': nrm(ks[16], (L, FILTER_INNER, FILTER_HIDDEN, FILTER_HIDDEN), FILTER_HIDDEN ** -0.5),
        'filt_b_inner': nrm(ks[17], (L, FILTER_INNER, FILTER_HIDDEN), 0.02),
        'filt_freq': gain(ks[18], (L, FILTER_HIDDEN)),
        'filt_w_out': nrm(ks[19], (L, FILTER_HIDDEN, 2 * HYENA_ORDER * D_HYENA), 0.1 * FILTER_HIDDEN ** -0.5),
        'hy_skip': nrm(ks[20], (L, HYENA_ORDER, D_HYENA), 0.1),
        'w_attn_out': nrm(ks[21], (L, ATTN_WIDTH, D_MODEL), ATTN_WIDTH ** -0.5),
        'w_hy_out': nrm(ks[22], (L, D_HYENA, D_MODEL), D_HYENA ** -0.5),
        'w_o': nrm(ks[23], (L, D_MODEL, D_MODEL), D_MODEL ** -0.5),
        'b_o': nrm(ks[24], (L, D_MODEL), 0.02),
        'w_up': nrm(ks[25], (L, D_MODEL, 2 * D_FF), D_MODEL ** -0.5),
        'b_up': nrm(ks[26], (L, 2 * D_FF), 0.02),
        'ffn_conv_w': nrm(ks[27], (L, CONV_W, 2 * D_FF), CONV_W ** -0.5),
        'ffn_conv_b': nrm(ks[28], (L, 2 * D_FF), 0.02),
        'w_down': nrm(ks[29], (L, D_FF, D_MODEL), D_FF ** -0.5),
        'b_down': nrm(ks[30], (L, D_MODEL), 0.02),
        'final_norm_w': gain(ks[31], (D_MODEL,)),
    }


def reference(x, c, ctx, c_ctx, w_mod, b_mod, norm1_w, norm2_w, w_in, b_in, q_norm_w, k_norm_w,
              hy_conv_w, hy_conv_b, filt_w1, filt_b1, filt_w_inner, filt_b_inner, filt_freq,
              filt_w_out, hy_skip, w_attn_out, w_hy_out, w_o, b_o, w_up, b_up, ffn_conv_w,
              ffn_conv_b, w_down, b_down, final_norm_w):
    cos, sin = axial_rope_tables(x.shape[1])
    xc = ctx
    for i in range(DEPTH):
        update_ctx = i < DEPTH - 1
        sh1, sc1, g1, sh2, sc2, g2 = modulation(c, w_mod[i], b_mod[i])
        csh1, csc1, cg1, csh2, csc2, cg2 = modulation(c_ctx[None], w_mod[i], b_mod[i])

        def hyena_i(streams):
            return hyena(streams, hy_conv_w[i], hy_conv_b[i], filt_w1[i], filt_b1[i], filt_w_inner[i],
                         filt_b_inner[i], filt_freq[i], filt_w_out[i], hy_skip[i])

        def merge_i(attn_o, hy_o, gates):
            return merge(attn_o, hy_o, gates, w_attn_out[i], w_hy_out[i], w_o[i], b_o[i])

        def ffn_i(h):
            return conv_ffn(h, w_up[i], b_up[i], ffn_conv_w[i], ffn_conv_b[i], w_down[i], b_down[i])

        h = modulate(x, norm1_w[i], sh1, sc1)
        hc = modulate(xc, norm1_w[i], csh1, csc1)
        q, k, v, hy, gates = split_proj(h @ w_in[i] + b_in[i])
        qc, kc, vc, hyc, gatesc = split_proj(hc @ w_in[i] + b_in[i])
        q = apply_rope(rmsnorm(q, q_norm_w[i]), cos, sin)
        k = apply_rope(rmsnorm(k, k_norm_w[i]), cos, sin)
        kc = rmsnorm(kc, k_norm_w[i])
        k_all = jnp.concatenate([kc, k], axis=1)
        v_all = jnp.concatenate([vc, v], axis=1)
        attn_o = attend(q, k_all, v_all)
        hy_o = hyena_i(hy)
        x_new = x + g1 * merge_i(attn_o, hy_o, gates)
        x_new = x_new + g2 * ffn_i(modulate(x_new, norm2_w[i], sh2, sc2))

        if update_ctx:
            qc = rmsnorm(qc, q_norm_w[i])
            attn_c = attend(qc, kc, vc)
            hy_c = hyena_i(hyc)
            xc = xc + cg1 * merge_i(attn_c, hy_c, gatesc)
            xc = xc + cg2 * ffn_i(modulate(xc, norm2_w[i], csh2, csc2))
        x = x_new
    return rmsnorm(x, final_norm_w)
```

```cpp
#include <hip/hip_runtime.h>
#include <hip/hip_cooperative_groups.h>
#include <hip/hip_bf16.h>
#include <cstdio>
#include <cstdint>
#include <cmath>
namespace cg = cooperative_groups;

#define LAS __attribute__((address_space(3)))
#define HD __host__ __device__ __forceinline__
typedef unsigned short bf16_t;
typedef short bf16x8 __attribute__((ext_vector_type(8)));
typedef float f32x4 __attribute__((ext_vector_type(4)));
typedef float f32x2 __attribute__((ext_vector_type(2)));
typedef float f32x16 __attribute__((ext_vector_type(16)));
typedef unsigned u32x4 __attribute__((ext_vector_type(4)));
typedef unsigned u32x2 __attribute__((ext_vector_type(2)));
typedef short s16x4 __attribute__((ext_vector_type(4)));

constexpr int NB = 4, SEQ = 8192, DM = 1024, CTXL = 256, MTOK = NB * SEQ;
constexpr int NHQ = 8, NHKV = 2, HDIM = 128, KVLEN = CTXL + SEQ;
constexpr int DHY = 512, DFF = 2816, PW = 5120, NMOD = 6 * DM;
constexpr float RMS_EPS = 1e-6f;
constexpr int NTHR = 512, NWAVE = 8;

constexpr size_t MiB = 1u << 20;
constexpr size_t WS_MODP = 1 * MiB;
constexpr size_t WS_MOD = 3 * MiB;
constexpr size_t WS_TW = 3 * MiB + 256 * 1024;
constexpr size_t WS_TW2 = WS_TW + 65536;
constexpr size_t WS_ROPE = 3 * MiB + 512 * 1024;
constexpr size_t WS_H3T = 4 * MiB;
constexpr size_t WS_WMAIN = 8 * MiB;
constexpr size_t WS_WHY = 15 * MiB;
constexpr size_t WS_WA = 18 * MiB;
constexpr size_t WS_WH = 20 * MiB;
constexpr size_t WS_WO = 21 * MiB;
constexpr size_t WS_WUP = 23 * MiB;
constexpr size_t WS_WDN = 34 * MiB;
constexpr size_t WS_Q = 40 * MiB;
constexpr size_t WS_K = 104 * MiB;
constexpr size_t WS_V = 121 * MiB;
constexpr size_t WS_HYT = 138 * MiB;
constexpr size_t WS_SG = 234 * MiB;
constexpr size_t WS_H = 362 * MiB;
constexpr size_t WS_HO = 426 * MiB;
constexpr size_t WS_END = 458 * MiB;
constexpr size_t KS_PER_WG = 4 * 16 * 512 * 8;

typedef __bf16 bf16x2_t __attribute__((ext_vector_type(2)));
__device__ __forceinline__ unsigned cvt_pk_bf16(float lo, float hi) { f32x2 v = {lo, hi}; bf16x2_t b = __builtin_convertvector(v, bf16x2_t); return __builtin_bit_cast(unsigned, b); }
__device__ __forceinline__ unsigned f2bf(float f) { unsigned u = __builtin_bit_cast(unsigned, f); return (u + 0x7fffu + ((u >> 16) & 1u)) >> 16; }
__device__ __forceinline__ float bf2f(unsigned short h) { return __builtin_bit_cast(float, (unsigned)h << 16); }
__device__ __forceinline__ float bflo(unsigned w) { return __builtin_bit_cast(float, w << 16); }
__device__ __forceinline__ float bfhi(unsigned w) { return __builtin_bit_cast(float, w & 0xffff0000u); }
__device__ __forceinline__ float wave_sum(float v) {
#pragma unroll
  for (int o = 1; o < 64; o <<= 1) v += __shfl_xor(v, o);
  return v;
}
__device__ __forceinline__ float sigmoidf_(float x) { return __builtin_amdgcn_rcpf(1.f + __expf(-x)); }
#define DPP_F(v, ctrl) __builtin_bit_cast(float, __builtin_amdgcn_update_dpp(0, __builtin_bit_cast(int, (v)), (ctrl), 0xF, 0xF, true))

namespace pg8 {
constexpr int BM = 256, BK = 64, HALF = 128, HTB = HALF * BK * 2, STAGE_BYTES = 8 * HTB, NXCD = 8, WGM = 8;
HD int lds_byte(int r, int c) { const int st = (r >> 4) * 2 + (c >> 5), rr = r & 15, cc = c & 31, ob = rr * 64 + cc * 2; return st * 1024 + (ob ^ (((ob >> 9) & 1) << 5)); }
HD void stage_rc(int b, int& R, int& C) { const int st = b / 1024, sb = b % 1024, swz = sb ^ (((sb >> 9) & 1) << 5); R = (st >> 1) * 16 + swz / 64; C = (st & 1) * 32 + (swz % 64) / 2; }
HD int perm32(int rho) { const int n = rho >> 4, i = rho & 15; return 8 * (i >> 2) + 4 * n + (i & 3); }
struct Unit { int pm, pn; };
struct StaticOrder {
  int nM, nN, nwg, G, c;
  HD void init(int nM_, int nN_, int G_, int c_) { nM = nM_; nN = nN_; nwg = nM * nN; G = G_; c = c_; }
  HD bool next(int i, Unit& u) const {
    const long L = (long)i * G + c; if (L >= nwg) return false;
    int wgid = (int)L; { const int q = nwg / NXCD, r = nwg % NXCD, xcd = wgid % NXCD, off = wgid / NXCD; wgid = (xcd < r ? xcd * (q + 1) : r * (q + 1) + (xcd - r) * q) + off; }
    const int nig = WGM * nN, gid = wgid / nig, fm = gid * WGM, gsz = (nM - fm) < WGM ? (nM - fm) : WGM;
    u.pm = fm + ((wgid % nig) % gsz); u.pn = (wgid % nig) / gsz; return true;
  }
};
struct AMapPlain { HD long tile_row(const Unit& u) const { return (long)u.pm * BM; } HD int row_in_half(int R) const { return R; } HD int half_rows() const { return HALF; } };
struct AMapUp { HD long tile_row(const Unit& u) const { return (long)u.pm * 252; } HD int row_in_half(int R) const { return (R >> 6) * 126 + 8 * (R & 15) + ((R >> 4) & 3); } HD int half_rows() const { return 4; } };

template <class Epi, class Sched, class AMap, bool ALIGN_EPI, bool SP2>
__device__ __forceinline__ void gemm_phase(LAS unsigned char* lds, const bf16_t* Aptr, const bf16_t* Btptr, const int K, const Sched& S, const Epi& E, const AMap AM) {
  int tid = threadIdx.x; asm volatile("" : "+v"(tid));
  const int wid = __builtin_amdgcn_readfirstlane(tid >> 6), lane = tid & 63, wr = wid >> 2, wc = wid & 3, fr = lane & 15, fq = lane >> 4;
  const int nt = K / BK;
  unsigned voffA[2], voffB[2];
#pragma unroll
  for (int i = 0; i < 2; ++i) { int R, C; stage_rc(tid * 16 + i * 8192, R, C); const int Rb = Epi::PERM ? ((R & ~31) + perm32(R & 31)) : R;
    voffA[i] = (unsigned)(AM.row_in_half(R) * K + C) * 2u; voffB[i] = (unsigned)(Rb * K + C) * 2u; }
  const size_t kstep = (size_t)(BK * 2);
  const size_t hstepB = (size_t)HALF * K * 2, hstepA = (size_t)AM.half_rows() * K * 2;
  const size_t tstepB = 2 * hstepB, rowA = (size_t)K * 2;
  const unsigned ldsw = (unsigned)wid * 1024u;
  const int aoff = lds_byte(wr * 64 + fr, fq * 8), boff = lds_byte(wc * 32 + fr, fq * 8);
#define PG8_SA(b, h) (((b) * 2 + (h)) * HTB)
#define PG8_SB(b, h) ((4 + (b) * 2 + (h)) * HTB)
#define PG8_STAGE(bufoff, gbase, voff) do { _Pragma("unroll") for (int _i = 0; _i < 2; ++_i) \
    __builtin_amdgcn_global_load_lds((const unsigned*)((const char*)(gbase) + (voff)[_i]), (LAS unsigned*)(lds + (bufoff) + ldsw + _i * 8192), 16, 0, 0); } while (0)
#define PG8_LDA(dst, b, h) do { _Pragma("unroll") for (int m = 0; m < 4; ++m) _Pragma("unroll") for (int k = 0; k < 2; ++k) dst[m][k] = *(const LAS bf16x8*)(lds + PG8_SA(b, h) + aoff + m * 2048 + k * 1024); } while (0)
#define PG8_LDB(dst, b, h) do { _Pragma("unroll") for (int n = 0; n < 2; ++n) _Pragma("unroll") for (int k = 0; k < 2; ++k) dst[n][k] = *(const LAS bf16x8*)(lds + PG8_SB(b, h) + boff + n * 2048 + k * 1024); } while (0)
#define PG8_MMA(ai, bj, At, Bt) do { __builtin_amdgcn_s_setprio(1); _Pragma("unroll") for (int m = 0; m < 4; ++m) _Pragma("unroll") for (int n = 0; n < 2; ++n) _Pragma("unroll") for (int k = 0; k < 2; ++k) \
    acc[ai][bj][m][n] = __builtin_amdgcn_mfma_f32_16x16x32_bf16(Bt[n][k], At[m][k], acc[ai][bj][m][n], 0, 0, 0); __builtin_amdgcn_s_setprio(0); } while (0)
#define PG8_WAIT_V(n) asm volatile("s_waitcnt vmcnt(" #n ")" ::: "memory")
#define PG8_WAIT_L(n) asm volatile("s_waitcnt lgkmcnt(" #n ")" ::: "memory")
#define PG8_BAR __builtin_amdgcn_s_barrier()
#define PG8_SCHED __builtin_amdgcn_sched_barrier(0)
  Unit cur, nxt; int ui = 0;
  if (!S.next(0, cur)) return;
  f32x4 acc[2][2][4][2];
#pragma unroll
  for (int a = 0; a < 2; ++a)
#pragma unroll
    for (int b = 0; b < 2; ++b)
#pragma unroll
      for (int m = 0; m < 4; ++m)
#pragma unroll
        for (int n = 0; n < 2; ++n) acc[a][b][m][n] = (f32x4){0.f, 0.f, 0.f, 0.f};
  bf16x8 At[4][2], B0[2][2], B1[2][2];
  const char* cA = (const char*)Aptr + (size_t)AM.tile_row(cur) * rowA; const char* cB = (const char*)Btptr + (size_t)cur.pn * tstepB;
  if constexpr (SP2) {
    PG8_STAGE(PG8_SB(0, 0), cB, voffB); PG8_STAGE(PG8_SB(0, 1), cB + hstepB, voffB); PG8_STAGE(PG8_SA(0, 0), cA, voffA); PG8_STAGE(PG8_SA(0, 1), cA + hstepA, voffA);
    if (wr == 1) PG8_BAR;
    PG8_WAIT_V(2); PG8_BAR;
    PG8_STAGE(PG8_SB(1, 0), cB + kstep, voffB); PG8_STAGE(PG8_SA(1, 0), cA + kstep, voffA); PG8_STAGE(PG8_SB(1, 1), cB + hstepB + kstep, voffB);
    PG8_WAIT_V(6); PG8_BAR;
  } else {
    PG8_STAGE(PG8_SB(0, 0), cB, voffB); PG8_STAGE(PG8_SA(0, 0), cA, voffA); PG8_STAGE(PG8_SB(0, 1), cB + hstepB, voffB); PG8_STAGE(PG8_SA(0, 1), cA + hstepA, voffA);
    if (wr == 1) PG8_BAR;
    PG8_WAIT_V(4); PG8_BAR;
    PG8_STAGE(PG8_SB(1, 0), cB + kstep, voffB); PG8_STAGE(PG8_SA(1, 0), cA + kstep, voffA); PG8_STAGE(PG8_SB(1, 1), cB + hstepB + kstep, voffB);
    PG8_WAIT_V(6); PG8_BAR;
  }
  for (;;) {
    const bool has_next = S.next(ui + 1, nxt);
    const char* nA = has_next ? (const char*)Aptr + (size_t)AM.tile_row(nxt) * rowA : cA; const char* nB = has_next ? (const char*)Btptr + (size_t)nxt.pn * tstepB : cB;
    for (int t = 0; t < nt; t += 2) {
      const bool last = (t == nt - 2);
      const char* a1 = cA + (size_t)(t + 1) * kstep;
      const char* a2 = last ? nA : cA + (size_t)(t + 2) * kstep; const char* b2 = last ? nB : cB + (size_t)(t + 2) * kstep;
      const char* a3 = a2 + kstep; const char* b3 = b2 + kstep;
      if constexpr (SP2) {
        PG8_LDB(B0, 0, 0); PG8_LDB(B1, 0, 1); PG8_SCHED; PG8_LDA(At, 0, 0); PG8_STAGE(PG8_SA(1, 1), a1 + hstepA, voffA);
        PG8_WAIT_V(8); PG8_WAIT_L(0); PG8_BAR; PG8_MMA(0, 0, At, B0); PG8_MMA(0, 1, At, B1); PG8_BAR; PG8_SCHED;
        PG8_LDA(At, 0, 1); PG8_STAGE(PG8_SB(0, 0), b2, voffB); PG8_STAGE(PG8_SB(0, 1), b2 + hstepB, voffB); PG8_STAGE(PG8_SA(0, 0), a2, voffA);
        PG8_WAIT_V(8); PG8_WAIT_L(0); PG8_BAR; PG8_MMA(1, 0, At, B0); PG8_MMA(1, 1, At, B1); PG8_BAR; PG8_SCHED;
        PG8_LDB(B0, 1, 0); PG8_LDB(B1, 1, 1); PG8_SCHED; PG8_LDA(At, 1, 0); PG8_STAGE(PG8_SA(0, 1), a2 + hstepA, voffA);
        PG8_WAIT_V(8); PG8_WAIT_L(0); PG8_BAR; PG8_MMA(0, 0, At, B0); PG8_MMA(0, 1, At, B1); PG8_BAR; PG8_SCHED;
        PG8_LDA(At, 1, 1); PG8_STAGE(PG8_SB(1, 0), b3, voffB); PG8_STAGE(PG8_SB(1, 1), b3 + hstepB, voffB); PG8_STAGE(PG8_SA(1, 0), a3, voffA);
        PG8_WAIT_V(8); PG8_WAIT_L(0); PG8_BAR; PG8_MMA(1, 0, At, B0); PG8_MMA(1, 1, At, B1); PG8_BAR; PG8_SCHED;
      } else {
        PG8_LDB(B0, 0, 0); PG8_SCHED; PG8_LDA(At, 0, 0); PG8_STAGE(PG8_SA(1, 1), a1 + hstepA, voffA);
        PG8_WAIT_L(8); PG8_BAR; PG8_WAIT_L(0); PG8_MMA(0, 0, At, B0); PG8_BAR; PG8_SCHED;
        PG8_LDB(B1, 0, 1); PG8_STAGE(PG8_SB(0, 0), b2, voffB);
        PG8_BAR; PG8_WAIT_L(0); PG8_MMA(0, 1, At, B1); PG8_BAR;
        PG8_LDA(At, 0, 1); PG8_STAGE(PG8_SA(0, 0), a2, voffA);
        PG8_BAR; PG8_WAIT_L(0); PG8_MMA(1, 0, At, B0); PG8_BAR; PG8_SCHED;
        PG8_STAGE(PG8_SB(0, 1), b2 + hstepB, voffB);
        PG8_WAIT_V(6); PG8_BAR; PG8_MMA(1, 1, At, B1); PG8_BAR;
        PG8_LDB(B0, 1, 0); PG8_SCHED; PG8_LDA(At, 1, 0); PG8_STAGE(PG8_SA(0, 1), a2 + hstepA, voffA);
        PG8_WAIT_L(8); PG8_BAR; PG8_WAIT_L(0); PG8_MMA(0, 0, At, B0); PG8_BAR; PG8_SCHED;
        PG8_LDB(B1, 1, 1); PG8_STAGE(PG8_SB(1, 0), b3, voffB);
        PG8_BAR; PG8_WAIT_L(0); PG8_MMA(0, 1, At, B1); PG8_BAR;
        PG8_LDA(At, 1, 1); PG8_STAGE(PG8_SA(1, 0), a3, voffA);
        PG8_BAR; PG8_WAIT_L(0); PG8_MMA(1, 0, At, B0); PG8_BAR; PG8_SCHED;
        PG8_STAGE(PG8_SB(1, 1), b3 + hstepB, voffB);
        PG8_WAIT_V(6); PG8_BAR; PG8_MMA(1, 1, At, B1); PG8_BAR;
      }
    }
    if constexpr (ALIGN_EPI) { if (wr == 0) PG8_BAR; }
    { int l_e = threadIdx.x; asm volatile("" : "+v"(l_e));
      E(acc, cur, wr, wc, l_e & 15, (l_e >> 4) & 3); }
    if (!has_next) break;
#pragma unroll
    for (int a = 0; a < 2; ++a)
#pragma unroll
      for (int b = 0; b < 2; ++b)
#pragma unroll
        for (int m = 0; m < 4; ++m)
#pragma unroll
          for (int n = 0; n < 2; ++n) acc[a][b][m][n] = (f32x4){0.f, 0.f, 0.f, 0.f};
    cur = nxt; cA = nA; cB = nB; ++ui;
    if constexpr (ALIGN_EPI) { if (wr == 1) PG8_BAR; }
  }
  PG8_WAIT_V(0);
  if constexpr (!ALIGN_EPI) { if (wr == 0) PG8_BAR; }
  PG8_BAR;
#undef PG8_SA
#undef PG8_SB
#undef PG8_STAGE
#undef PG8_LDA
#undef PG8_LDB
#undef PG8_MMA
#undef PG8_WAIT_V
#undef PG8_WAIT_L
#undef PG8_BAR
#undef PG8_SCHED
}

typedef f32x4 Acc[2][2][4][2];
__device__ __forceinline__ u32x4 pack8(const f32x4 a, const f32x4 b) { u32x4 w; w.x = cvt_pk_bf16(a[0], a[1]); w.y = cvt_pk_bf16(a[2], a[3]); w.z = cvt_pk_bf16(b[0], b[1]); w.w = cvt_pk_bf16(b[2], b[3]); return w; }
__device__ __forceinline__ void unpack8(const u32x4 w, f32x4& a, f32x4& b) { a = (f32x4){bflo(w.x), bfhi(w.x), bflo(w.y), bfhi(w.y)}; b = (f32x4){bflo(w.z), bfhi(w.z), bflo(w.w), bfhi(w.w)}; }

struct EpiInProj {
  static constexpr bool PERM = true;
  bf16_t *Q, *Kb, *Vb, *SG; const float *b_in, *qnw, *knw; const f32x2* rope; LAS float* red;
  __device__ __forceinline__ void operator()(Acc& acc, const Unit& u, int wr, int wc, int fr, int fq) const {
    const int pn = u.pn, cl = wc * 32 + 8 * fq, borig = pn * 256 + (pn >= 6 ? 1536 : 0);
    f32x4 bv[2][2];
#pragma unroll
    for (int bj = 0; bj < 2; ++bj)
#pragma unroll
      for (int n = 0; n < 2; ++n) bv[bj][n] = *(const f32x4*)(b_in + borig + bj * 128 + cl + 4 * n);
    const int row0 = u.pm * 256 + wr * 64 + fr;
    if (pn >= 6) {
#pragma unroll
      for (int ai = 0; ai < 2; ++ai)
#pragma unroll
        for (int m = 0; m < 4; ++m) { bf16_t* rowp = SG + (size_t)(row0 + ai * 128 + m * 16) * 2048 + (pn - 6) * 256 + cl;
#pragma unroll
          for (int bj = 0; bj < 2; ++bj) { f32x4 v0 = acc[ai][bj][m][0] + bv[bj][0], v1 = acc[ai][bj][m][1] + bv[bj][1];
#pragma unroll
            for (int e = 0; e < 4; ++e) { v0[e] = sigmoidf_(v0[e]); v1[e] = sigmoidf_(v1[e]); }
            *(u32x4*)(rowp + bj * 128) = pack8(v0, v1); } asm volatile("" ::: "memory"); __builtin_amdgcn_sched_barrier(0); }
    } else if (pn == 5) {
#pragma unroll
      for (int ai = 0; ai < 2; ++ai)
#pragma unroll
        for (int m = 0; m < 4; ++m) { const int grow = row0 + ai * 128 + m * 16, b = grow >> 13, t = grow & 8191; bf16_t* rowp = Vb + ((size_t)b * KVLEN + CTXL + t) * 256 + cl;
#pragma unroll
          for (int bj = 0; bj < 2; ++bj) *(u32x4*)(rowp + bj * 128) = pack8(acc[ai][bj][m][0] + bv[bj][0], acc[ai][bj][m][1] + bv[bj][1]); }
    } else {
#pragma unroll
      for (int ai = 0; ai < 2; ++ai)
#pragma unroll
        for (int m = 0; m < 4; ++m)
#pragma unroll
          for (int bj = 0; bj < 2; ++bj) { const f32x4 v0 = acc[ai][bj][m][0] + bv[bj][0], v1 = acc[ai][bj][m][1] + bv[bj][1]; acc[ai][bj][m][0] = v0; acc[ai][bj][m][1] = v1;
            float s = (v0[0] * v0[0] + v0[1] * v0[1]) + (v0[2] * v0[2] + v0[3] * v0[3]) + (v1[0] * v1[0] + v1[1] * v1[1]) + (v1[2] * v1[2] + v1[3] * v1[3]);
            s += __builtin_bit_cast(float, __builtin_amdgcn_ds_swizzle(__builtin_bit_cast(int, s), 0x401F));
            { auto rr = __builtin_amdgcn_permlane32_swap(__float_as_uint(s), __float_as_uint(s), false, false); s = __uint_as_float(rr[0]) + __uint_as_float(rr[1]); }
            if (fq == 0) red[((ai * 128 + wr * 64 + m * 16 + fr) * 2 + bj) * 4 + wc] = s; }
      asm volatile("s_waitcnt lgkmcnt(0)" ::: "memory"); __builtin_amdgcn_s_barrier(); asm volatile("" ::: "memory");
      const float* nwp = (pn == 4) ? knw : qnw;
      const f32x4 nw0 = *(const f32x4*)(nwp + cl), nw1 = *(const f32x4*)(nwp + cl + 4);
#pragma unroll
      for (int ai = 0; ai < 2; ++ai)
#pragma unroll
        for (int m = 0; m < 4; ++m) { const int rit = ai * 128 + wr * 64 + m * 16 + fr, grow = u.pm * 256 + rit, b = grow >> 13, t = grow & 8191;
          const int pos = (wc < 2) ? (t >> 6) : (t & 63);
          const f32x4* rp = (const f32x4*)(rope + pos * 32 + (wc & 1) * 16 + 4 * fq);
          const f32x4 cs0 = rp[0], cs1 = rp[1];
#pragma unroll
          for (int bj = 0; bj < 2; ++bj) { const f32x4 tt = *(const LAS f32x4*)(red + (rit * 2 + bj) * 4);
            const float rs = rsqrtf(((tt[0] + tt[1]) + (tt[2] + tt[3])) * (1.f / 128.f) + RMS_EPS);
            const f32x4 y0 = acc[ai][bj][m][0] * rs * nw0, y1 = acc[ai][bj][m][1] * rs * nw1;
            f32x4 o0, o1;
            o0[0] = y0[0] * cs0[0] - y0[1] * cs0[1]; o0[1] = y0[0] * cs0[1] + y0[1] * cs0[0];
            o0[2] = y0[2] * cs0[2] - y0[3] * cs0[3]; o0[3] = y0[2] * cs0[3] + y0[3] * cs0[2];
            o1[0] = y1[0] * cs1[0] - y1[1] * cs1[1]; o1[1] = y1[0] * cs1[1] + y1[1] * cs1[0];
            o1[2] = y1[2] * cs1[2] - y1[3] * cs1[3]; o1[3] = y1[2] * cs1[3] + y1[3] * cs1[2];
            bf16_t* dst = (pn == 4) ? Kb + ((size_t)b * KVLEN + CTXL + t) * 256 + bj * 128 + cl : Q + (size_t)grow * 1024 + pn * 256 + bj * 128 + cl;
            *(u32x4*)dst = pack8(o0, o1); } asm volatile("" ::: "memory"); __builtin_amdgcn_sched_barrier(0); }
    }
  }
};
struct EpiHy {
  static constexpr bool PERM = true;
  bf16_t* HYT; const float* b_in;
  __device__ __forceinline__ void operator()(Acc& acc, const Unit& u, int wr, int wc, int fr, int fq) const {
    const int ch0 = u.pm * 256 + wr * 64 + fr, tok0 = u.pn * 256 + wc * 32 + 8 * fq;
#pragma unroll
    for (int ai = 0; ai < 2; ++ai)
#pragma unroll
      for (int m = 0; m < 4; ++m) { const int ch = ch0 + ai * 128 + m * 16; const float bs = b_in[1536 + ch]; bf16_t* rowp = HYT + (size_t)ch * MTOK + tok0;
#pragma unroll
        for (int bj = 0; bj < 2; ++bj) *(u32x4*)(rowp + bj * 128) = pack8(acc[ai][bj][m][0] + bs, acc[ai][bj][m][1] + bs); }
  }
};
template <int PASS> struct EpiMerge {
  static constexpr bool PERM = true;
  bf16_t* MIX; const bf16_t* SG;
  __device__ __forceinline__ void operator()(Acc& acc, const Unit& u, int wr, int wc, int fr, int fq) const {
    const int row0 = u.pm * 256 + wr * 64 + fr, col0 = u.pn * 256 + wc * 32 + 8 * fq;
#pragma unroll
    for (int ai = 0; ai < 2; ++ai)
#pragma unroll
      for (int m = 0; m < 4; ++m) { const size_t row = (size_t)(row0 + ai * 128 + m * 16);
#pragma unroll
        for (int bj = 0; bj < 2; ++bj) { const int col = col0 + bj * 128; f32x4 g0, g1; unpack8(*(const u32x4*)(SG + row * 2048 + PASS * 1024 + col), g0, g1);
          f32x4 v0 = acc[ai][bj][m][0] * g0, v1 = acc[ai][bj][m][1] * g1;
          if (PASS == 1) { f32x4 p0, p1; unpack8(*(const u32x4*)(MIX + row * 1024 + col), p0, p1); v0 += p0; v1 += p1; }
          *(u32x4*)(MIX + row * 1024 + col) = pack8(v0, v1); } }
  }
};
struct EpiGateRes {
  static constexpr bool PERM = false;
  const float* base; float* out; const float* bias; const float* gate;
  __device__ __forceinline__ void operator()(Acc& acc, const Unit& u, int wr, int wc, int fr, int fq) const {
    const int row0 = u.pm * 256 + wr * 64 + fr, col0 = u.pn * 256 + wc * 32 + 4 * fq, b = (u.pm * 256) >> 13;
    f32x4 bv[2][2], gv[2][2];
#pragma unroll
    for (int bj = 0; bj < 2; ++bj)
#pragma unroll
      for (int n = 0; n < 2; ++n) { bv[bj][n] = *(const f32x4*)(bias + col0 + bj * 128 + n * 16); gv[bj][n] = *(const f32x4*)(gate + b * NMOD + col0 + bj * 128 + n * 16); }
#pragma unroll
    for (int ai = 0; ai < 2; ++ai)
#pragma unroll
      for (int m = 0; m < 4; ++m) { const size_t off = (size_t)(row0 + ai * 128 + m * 16) * 1024 + col0;
#pragma unroll
        for (int bj = 0; bj < 2; ++bj)
#pragma unroll
          for (int n = 0; n < 2; ++n) { const f32x4 bs = *(const f32x4*)(base + off + bj * 128 + n * 16); *(f32x4*)(out + off + bj * 128 + n * 16) = bs + gv[bj][n] * (acc[ai][bj][m][n] + bv[bj][n]); }
        asm volatile("" ::: "memory"); __builtin_amdgcn_sched_barrier(0); }
  }
};
struct EpiUp {
  static constexpr bool PERM = true;
  bf16_t* F; const float *b_up, *cw, *cb;
  __device__ __forceinline__ void operator()(Acc& acc, const Unit& u, int wr, int wc, int fr, int fq) const {
    const int pn = u.pn, cl = wc * 32 + 8 * fq, tok0 = 252 * u.pm + wr * 126 - 1 + 8 * fr;
    const int jz = (-tok0) & 8191, jl = (8191 - tok0) & 8191;
#pragma unroll
    for (int bj = 0; bj < 2; ++bj)
#pragma unroll
      for (int n = 0; n < 2; ++n) { const int col4 = bj * DFF + pn * 128 + cl + 4 * n;
        const f32x4 bu = *(const f32x4*)(b_up + col4), w0 = *(const f32x4*)(cw + col4), w1 = *(const f32x4*)(cw + 2 * DFF + col4), w2 = *(const f32x4*)(cw + 4 * DFF + col4), cbv = *(const f32x4*)(cb + col4);
        f32x4 p, nl;
#pragma unroll
        for (int e = 0; e < 4; ++e) { p[e] = DPP_F(acc[1][bj][3][n][e], 0x111); nl[e] = DPP_F(acc[0][bj][0][n][e], 0x101); }
        const f32x4 kall = bu * (w0 + w1 + w2) + cbv;
#pragma unroll
        for (int j8 = 0; j8 < 8; ++j8) { const int ai = j8 >> 2, m = j8 & 3;
          const f32x4 cur = acc[ai][bj][m][n];
          f32x4 nx; if (j8 < 7) nx = acc[(j8 + 1) >> 2][bj][(j8 + 1) & 3][n]; else nx = nl;
          const float mp = (j8 == jz) ? 0.f : 1.f, mn = (j8 == jl) ? 0.f : 1.f;
          const f32x4 w0m = w0 * mp, w2m = w2 * mn;
          const f32x4 kk = (j8 == jz || j8 == jl) ? (bu * (w0m + w1 + w2m) + cbv) : kall;
          acc[ai][bj][m][n] = w0m * p + w1 * cur + w2m * nx + kk; p = cur; }
        asm volatile("" : "+v"(acc[0][bj][0][n]), "+v"(acc[0][bj][1][n]), "+v"(acc[0][bj][2][n]), "+v"(acc[0][bj][3][n]), "+v"(acc[1][bj][0][n]), "+v"(acc[1][bj][1][n]), "+v"(acc[1][bj][2][n]), "+v"(acc[1][bj][3][n]));
        asm volatile("" ::: "memory"); __builtin_amdgcn_sched_barrier(0); }
#pragma unroll
    for (int j8 = 0; j8 < 8; ++j8) { const int ai = j8 >> 2, m = j8 & 3, tok = tok0 + j8;
      const bool valid = (tok >= 0) && (tok < MTOK) && !(fr == 0 && j8 == 0) && !(fr == 15 && j8 == 7);
      f32x4 o[2];
#pragma unroll
      for (int n = 0; n < 2; ++n) { const f32x4 a = acc[ai][0][m][n], g = acc[ai][1][m][n];
#pragma unroll
        for (int e = 0; e < 4; ++e) { const float z = 1.5957691216057308f * (a[e] + 0.044715f * a[e] * a[e] * a[e]); o[n][e] = a[e] * sigmoidf_(z) * g[e]; } }
      if (valid) *(u32x4*)(F + (size_t)tok * DFF + pn * 128 + cl) = pack8(o[0], o[1]); asm volatile("" ::: "memory"); __builtin_amdgcn_sched_barrier(0); }
  }
};
}

namespace attn {
constexpr int D = 128, NW = 8, QBLK = 32, KVBLK = 64;
constexpr float SCALE = 0.088388347648318440f;
constexpr float THR = 8.f;
constexpr int LDQ = 1024, LDK = 256, LDO = 1024;
constexpr size_t SHM_V = KVBLK * D * 2, SHM_K = KVBLK * D * 2, SHM_ATTN = 2 * SHM_V + 2 * SHM_K + NW * 64 * 4;
#define KSWZ(row, colB) ((row) * 256 + ((colB) ^ (((row) & 7) << 4)))
#define SBAR() __builtin_amdgcn_sched_barrier(0)
__device__ __forceinline__ int crow(int r, int hi) { return (r & 3) + 8 * (r >> 2) + 4 * hi; }
__device__ __forceinline__ void partialSM(f32x16& p0, f32x16& p1, float& m_reg, float& mn, float& alpha) {
  constexpr float C = SCALE * 1.4426950408889634f;
  float pmax = p0[0];
#pragma unroll
  for (int r = 1; r < 16; ++r) pmax = fmaxf(pmax, p0[r]);
#pragma unroll
  for (int r = 0; r < 16; ++r) pmax = fmaxf(pmax, p1[r]);
  { auto rr = __builtin_amdgcn_permlane32_swap(__float_as_uint(pmax), __float_as_uint(pmax), false, false);
    pmax = fmaxf(__uint_as_float(rr[0]), __uint_as_float(rr[1])); }
  if (__builtin_expect(__all(pmax - m_reg <= THR / SCALE), 1)) { mn = m_reg; alpha = 1.f; }
  else { mn = fmaxf(m_reg, pmax); alpha = __builtin_amdgcn_exp2f((m_reg - mn) * C); m_reg = mn; }
  float mnC = -mn * C;
#pragma unroll
  for (int r = 0; r < 16; ++r) p0[r] = fmaf(p0[r], C, mnC);
#pragma unroll
  for (int r = 0; r < 16; ++r) p1[r] = fmaf(p1[r], C, mnC);
#pragma unroll
  for (int r = 0; r < 16; ++r) p0[r] = __builtin_amdgcn_exp2f(p0[r]);
}
__device__ __forceinline__ void finishSM(f32x16& p0, f32x16& p1, float alpha, float& l_reg, bf16x8& pa0, bf16x8& pa1, bf16x8& pa2, bf16x8& pa3) {
#pragma unroll
  for (int r = 0; r < 16; ++r) p1[r] = __builtin_amdgcn_exp2f(p1[r]);
  float ps = 0;
#pragma unroll
  for (int r = 0; r < 16; ++r) ps += p0[r];
#pragma unroll
  for (int r = 0; r < 16; ++r) ps += p1[r];
  { auto rr = __builtin_amdgcn_permlane32_swap(__float_as_uint(ps), __float_as_uint(ps), false, false);
    ps = __uint_as_float(rr[0]) + __uint_as_float(rr[1]); }
  l_reg = l_reg * alpha + ps;
#define PK4(P, BASE, OUT) do { unsigned a0 = cvt_pk_bf16(P[BASE + 0], P[BASE + 1]), a1 = cvt_pk_bf16(P[BASE + 2], P[BASE + 3]);   \
    unsigned b0 = cvt_pk_bf16(P[BASE + 4], P[BASE + 5]), b1 = cvt_pk_bf16(P[BASE + 6], P[BASE + 7]);                              \
    auto r0 = __builtin_amdgcn_permlane32_swap(a0, b0, false, false); auto r1 = __builtin_amdgcn_permlane32_swap(a1, b1, false, false); \
    u32x4 w = {r0[0], r1[0], r0[1], r1[1]}; OUT = *reinterpret_cast<bf16x8*>(&w); } while (0)
  PK4(p0, 0, pa0); PK4(p0, 8, pa1); PK4(p1, 0, pa2); PK4(p1, 8, pa3);
#undef PK4
}
__device__ __forceinline__ void qkt(f32x16& p0, f32x16& p1, const char* Ks, const bf16x8* qr, int r32, int hi) {
  p0 = f32x16{}; p1 = f32x16{};
#pragma unroll
  for (int d0 = 0; d0 < 8; ++d0) { int cb = (d0 * 16 + hi * 8) * 2;
    bf16x8 b0 = *reinterpret_cast<const bf16x8*>(Ks + KSWZ(r32, cb));
    bf16x8 b1 = *reinterpret_cast<const bf16x8*>(Ks + KSWZ(32 + r32, cb));
    p0 = __builtin_amdgcn_mfma_f32_32x32x16_bf16(b0, qr[d0], p0, 0, 0, 0);
    p1 = __builtin_amdgcn_mfma_f32_32x32x16_bf16(b1, qr[d0], p1, 0, 0, 0); }
}
__device__ __forceinline__ int v_st(int k, int c) { const int kk = (k & ~0xC) | ((k & 4) << 1) | ((k & 8) >> 1); return ((kk >> 3) * 4 + (c >> 5)) * 512 + ((kk & 7) * 32 + (c & 31)) * 2; }
__device__ __forceinline__ int v_rd_base(int lane) { return ((lane & 3) << 3) | (((lane >> 2) & 3) << 6) | (((lane >> 4) & 1) << 5) | (((lane >> 5) & 1) << 8); }
constexpr int v_rd_off(int d0, int ks, int half) { return d0 * 512 + ks * 4096 + half * 2048; }
template <int OFF> __device__ __forceinline__ s16x4 tr_read(int vb) {
  s16x4 r; asm volatile("ds_read_b64_tr_b16 %0, %1 offset:%2" : "=&v"(r) : "v"(vb), "i"(OFF) : "memory"); return r;
}
template <int D0> __device__ __forceinline__ void pv_one(f32x16& od, int vb, bf16x8 pa0, bf16x8 pa1, bf16x8 pa2, bf16x8 pa3) {
  const s16x4 l0 = tr_read<v_rd_off(D0, 0, 0)>(vb), h0 = tr_read<v_rd_off(D0, 0, 1)>(vb), l1 = tr_read<v_rd_off(D0, 1, 0)>(vb), h1 = tr_read<v_rd_off(D0, 1, 1)>(vb);
  const s16x4 l2 = tr_read<v_rd_off(D0, 2, 0)>(vb), h2 = tr_read<v_rd_off(D0, 2, 1)>(vb), l3 = tr_read<v_rd_off(D0, 3, 0)>(vb), h3 = tr_read<v_rd_off(D0, 3, 1)>(vb);
  asm volatile("s_waitcnt lgkmcnt(0)" ::: "memory"); SBAR();
#define PK(L, H) (bf16x8){L[0], L[1], L[2], L[3], H[0], H[1], H[2], H[3]}
  od = __builtin_amdgcn_mfma_f32_32x32x16_bf16(pa0, PK(l0, h0), od, 0, 0, 0);
  od = __builtin_amdgcn_mfma_f32_32x32x16_bf16(pa1, PK(l1, h1), od, 0, 0, 0);
  od = __builtin_amdgcn_mfma_f32_32x32x16_bf16(pa2, PK(l2, h2), od, 0, 0, 0);
  od = __builtin_amdgcn_mfma_f32_32x32x16_bf16(pa3, PK(l3, h3), od, 0, 0, 0);
#undef PK
}
__device__ __forceinline__ void pv_d0(f32x16* o, int vb, bf16x8 pa0, bf16x8 pa1, bf16x8 pa2, bf16x8 pa3) {
  pv_one<0>(o[0], vb, pa0, pa1, pa2, pa3); pv_one<1>(o[1], vb, pa0, pa1, pa2, pa3); pv_one<2>(o[2], vb, pa0, pa1, pa2, pa3); pv_one<3>(o[3], vb, pa0, pa1, pa2, pa3);
}
__device__ __forceinline__ void attn_dense_body(const bf16_t* __restrict__ Qb, const bf16_t* __restrict__ Kh, const bf16_t* __restrict__ Vh, bf16_t* __restrict__ Ob, int seq, char* lds) {
  const int tid = threadIdx.x, wid = tid >> 6, lane = tid & 63, r32 = lane & 31, hi = lane >> 5;
  char* V_lds = lds; char* K_lds = lds + 2 * SHM_V;
  float* ws = (float*)(lds + 2 * SHM_V + 2 * SHM_K) + wid * 64; float* li_l = ws; float* al_l = ws + 32;
  float m_reg = -1e30f, l_reg = 0; f32x16 o[4] = {}; bf16x8 qr[8];
  const bf16_t* Qw = Qb + (long)(wid * QBLK + r32) * LDQ + hi * 8;
#pragma unroll
  for (int d0 = 0; d0 < 8; ++d0) qr[d0] = *reinterpret_cast<const bf16x8*>(Qw + d0 * 16);
  const int sr = tid >> 4, sc = (tid & 15) * 8, vst0 = v_st(sr, sc), vst1 = v_st(32 + sr, sc);
  const int vb0 = (int)(uintptr_t)V_lds + v_rd_base(lane);
  struct { bf16x8 vs0, vs1, ks0, ks1; } sr_[2];
#define SLOAD(i, k0) do { sr_[i].vs0 = *reinterpret_cast<const bf16x8*>(&Vh[(long)((k0) + sr) * LDK + sc]); sr_[i].vs1 = *reinterpret_cast<const bf16x8*>(&Vh[(long)((k0) + 32 + sr) * LDK + sc]); \
    sr_[i].ks0 = *reinterpret_cast<const bf16x8*>(&Kh[(long)((k0) + sr) * LDK + sc]); sr_[i].ks1 = *reinterpret_cast<const bf16x8*>(&Kh[(long)((k0) + 32 + sr) * LDK + sc]); } while (0)
#define SWRITE(b, i) do { *(bf16x8*)(V_lds + (b) * SHM_V + vst0) = sr_[i].vs0;          \
    *(bf16x8*)(V_lds + (b) * SHM_V + vst1) = sr_[i].vs1; int kc = sc * 2;               \
    *(bf16x8*)(K_lds + (b) * SHM_K + KSWZ(sr, kc)) = sr_[i].ks0;                       \
    *(bf16x8*)(K_lds + (b) * SHM_K + KSWZ(32 + sr, kc)) = sr_[i].ks1; } while (0)
#define SWAIT() asm volatile("s_waitcnt vmcnt(4)" ::: "memory")
#define RESC(a) do { if (__any((a) < 1.f)) { if (hi == 0) al_l[r32] = (a); asm volatile("s_waitcnt lgkmcnt(0)" ::: "memory"); \
    _Pragma("unroll") for (int d = 0; d < 4; ++d) _Pragma("unroll") for (int r = 0; r < 16; ++r) o[d][r] *= al_l[crow(r, hi)]; } } while (0)
  f32x16 pA0, pA1, pB0, pB1; float mnA, mnB, alA, alB; bf16x8 pa0, pa1, pa2, pa3; const int NT = seq / KVBLK;
  constexpr int SE = 0, SO = 1;
  SLOAD(SE, 0); asm volatile("s_waitcnt vmcnt(0)" ::: "memory"); SWRITE(0, SE); __syncthreads();
  qkt(pA0, pA1, K_lds, qr, r32, hi); partialSM(pA0, pA1, m_reg, mnA, alA);
  SLOAD(SO, KVBLK); if (2 < NT) SLOAD(SE, 2 * KVBLK);
  SWAIT(); SWRITE(1, SO); __syncthreads();
  for (int j = 1; j + 1 < NT; j += 2) {
    SBAR(); qkt(pB0, pB1, K_lds + SHM_K, qr, r32, hi);
    finishSM(pA0, pA1, alA, l_reg, pa0, pa1, pa2, pa3); SBAR();
    SLOAD(SO, (j + 2) * KVBLK); SBAR();
    pv_d0(o, vb0, pa0, pa1, pa2, pa3); partialSM(pB0, pB1, m_reg, mnB, alB);
    __syncthreads(); SWAIT(); SWRITE(0, SE);
    RESC(alB); __syncthreads();
    SBAR(); qkt(pA0, pA1, K_lds, qr, r32, hi);
    finishSM(pB0, pB1, alB, l_reg, pa0, pa1, pa2, pa3); SBAR();
    if (j + 3 < NT) SLOAD(SE, (j + 3) * KVBLK); SBAR();
    pv_d0(o, vb0 + (int)SHM_V, pa0, pa1, pa2, pa3); partialSM(pA0, pA1, m_reg, mnA, alA);
    __syncthreads(); SWAIT(); SWRITE(1, SO);
    RESC(alA); __syncthreads();
  }
  SBAR(); qkt(pB0, pB1, K_lds + SHM_K, qr, r32, hi);
  finishSM(pA0, pA1, alA, l_reg, pa0, pa1, pa2, pa3); SBAR();
  pv_d0(o, vb0, pa0, pa1, pa2, pa3); partialSM(pB0, pB1, m_reg, mnB, alB);
  __syncthreads(); RESC(alB);
  finishSM(pB0, pB1, alB, l_reg, pa0, pa1, pa2, pa3); SBAR();
  pv_d0(o, vb0 + (int)SHM_V, pa0, pa1, pa2, pa3);
  if (hi == 0) li_l[r32] = l_reg; asm volatile("s_waitcnt lgkmcnt(0)" ::: "memory");
  float rli[16];
#pragma unroll
  for (int r = 0; r < 16; ++r) rli[r] = __builtin_amdgcn_rcpf(li_l[crow(r, hi)]);
  bf16_t* Ow = Ob + (long)(wid * QBLK) * LDO;
#pragma unroll
  for (int r = 0; r < 16; ++r) { int orow = crow(r, hi);
#pragma unroll
    for (int d0 = 0; d0 < 4; ++d0) Ow[(long)orow * LDO + d0 * 32 + r32] = (bf16_t)f2bf(o[d0][r] * rli[r]); }
  __syncthreads();
#undef SLOAD
#undef SWRITE
#undef SWAIT
#undef RESC
}
#undef KSWZ
#undef SBAR
}

namespace hf {
constexpr float C16_1 = 0.92387953251128674f, S16_1 = 0.38268343236508977f, RH = 0.70710678118654752f;
template <bool INV> HD void dft4(float& r0, float& i0, float& r1, float& i1, float& r2, float& i2, float& r3, float& i3) {
  const float t0r = r0 + r2, t0i = i0 + i2, t1r = r0 - r2, t1i = i0 - i2;
  const float t2r = r1 + r3, t2i = i1 + i3, t3r = r1 - r3, t3i = i1 - i3;
  r0 = t0r + t2r; i0 = t0i + t2i; r2 = t0r - t2r; i2 = t0i - t2i;
  if (!INV) { r1 = t1r + t3i; i1 = t1i - t3r; r3 = t1r - t3i; i3 = t1i + t3r; }
  else      { r1 = t1r - t3i; i1 = t1i + t3r; r3 = t1r + t3i; i3 = t1i - t3r; }
}
template <bool INV> HD void cmul(float& r, float& i, float c, float s) { const float ss = INV ? -s : s; const float nr = r * c - i * ss, ni = r * ss + i * c; r = nr; i = ni; }
template <bool INV> HD void dft16(float (&re)[16], float (&im)[16]) {
#pragma unroll
  for (int n2 = 0; n2 < 4; ++n2) dft4<INV>(re[n2], im[n2], re[n2 + 4], im[n2 + 4], re[n2 + 8], im[n2 + 8], re[n2 + 12], im[n2 + 12]);
  cmul<INV>(re[5], im[5], C16_1, -S16_1); cmul<INV>(re[6], im[6], RH, -RH); cmul<INV>(re[7], im[7], S16_1, -C16_1);
  cmul<INV>(re[9], im[9], RH, -RH); cmul<INV>(re[10], im[10], 0.f, -1.f); cmul<INV>(re[11], im[11], -RH, -RH);
  cmul<INV>(re[13], im[13], S16_1, -C16_1); cmul<INV>(re[14], im[14], -RH, -RH); cmul<INV>(re[15], im[15], -C16_1, S16_1);
#pragma unroll
  for (int k1 = 0; k1 < 4; ++k1) dft4<INV>(re[4 * k1], im[4 * k1], re[4 * k1 + 1], im[4 * k1 + 1], re[4 * k1 + 2], im[4 * k1 + 2], re[4 * k1 + 3], im[4 * k1 + 3]);
#pragma unroll
  for (int a = 0; a < 4; ++a)
#pragma unroll
    for (int b = a + 1; b < 4; ++b) { float t = re[4 * a + b]; re[4 * a + b] = re[4 * b + a]; re[4 * b + a] = t; t = im[4 * a + b]; im[4 * a + b] = im[4 * b + a]; im[4 * b + a] = t; }
}
template <bool INV> HD void twchain(float (&re)[16], float (&im)[16], float br, float bi, float tr, float ti) {
  float cr = br, ci = INV ? -bi : bi; const float tti = INV ? -ti : ti;
#pragma unroll
  for (int i = 0; i < 16; ++i) {
    const float nr = re[i] * cr - im[i] * ci, ni = re[i] * ci + im[i] * cr; re[i] = nr; im[i] = ni;
    const float ncr = cr * tr - ci * tti, nci = cr * tti + ci * tr; cr = ncr; ci = nci;
  }
}
HD int e1_w(int t, int s) { return s * 512 + t; }
HD int e1_r(int t, int s) { return (t >> 5) * 512 + s * 32 + (t & 31); }
HD int e2_w(int t, int s) { const int k1 = t >> 5, n3 = t & 31; return ((k1 * 16 + s) * 2 + (n3 >> 4)) * 17 + (n3 & 15); }
HD int e2_r(int t, int s) { return t * 17 + s; }
constexpr int E2_SIZE = 512 * 17;
HD float W32C(int j) { constexpr float C[16] = {1.f, 0.98078528040323043f, 0.92387953251128674f, 0.83146961230254524f, 0.70710678118654752f, 0.55557023301960218f, 0.38268343236508977f, 0.19509032201612825f,
                            0.f, -0.19509032201612825f, -0.38268343236508977f, -0.55557023301960218f, -0.70710678118654752f, -0.83146961230254524f, -0.92387953251128674f, -0.98078528040323043f}; return C[j]; }
HD float W32S(int j) { constexpr float S[16] = {0.f, 0.19509032201612825f, 0.38268343236508977f, 0.55557023301960218f, 0.70710678118654752f, 0.83146961230254524f, 0.92387953251128674f, 0.98078528040323043f,
                            1.f, 0.98078528040323043f, 0.92387953251128674f, 0.83146961230254524f, 0.70710678118654752f, 0.55557023301960218f, 0.38268343236508977f, 0.19509032201612825f}; return S[j]; }
__device__ __forceinline__ void fft_fwd(float (&re)[16], float (&im)[16], int tid, LAS f32x2* E1, LAS f32x2* E2, const f32x2* TW) {
  __syncthreads();
  dft16<false>(re, im);
#pragma unroll
  for (int s = 0; s < 16; ++s) E1[e1_w(tid, s)] = (f32x2){re[s], im[s]};
  __syncthreads();
#pragma unroll
  for (int s = 0; s < 16; ++s) { const f32x2 v = E1[e1_r(tid, s)]; re[s] = v.x; im[s] = v.y; }
  { const f32x2 th = TW[32 * (tid >> 5)]; twchain<false>(re, im, 1.f, 0.f, th.x, th.y); }
  dft16<false>(re, im);
#pragma unroll
  for (int s = 0; s < 16; ++s) E2[e2_w(tid, s)] = (f32x2){re[s], im[s]};
  __syncthreads();
#pragma unroll
  for (int s = 0; s < 16; ++s) { const f32x2 v = E2[e2_r(tid, s)]; re[s] = v.x; im[s] = v.y; }
  const int h = tid & 1, q = (tid >> 5) + 16 * ((tid >> 1) & 15);
  { const f32x2 bs = TW[(16 * h * q) & 8191], th = TW[q]; twchain<false>(re, im, bs.x, bs.y, th.x, th.y); }
#pragma unroll
  for (int s = 0; s < 16; ++s) { const float pr = DPP_F(re[s], 0xB1), pi = DPP_F(im[s], 0xB1);
    const float sr_ = re[s] + pr, si_ = im[s] + pi; float dr = pr - re[s], di = pi - im[s]; cmul<false>(dr, di, W32C(s), -W32S(s));
    re[s] = h ? dr : sr_; im[s] = h ? di : si_; }
  dft16<false>(re, im);
}
__device__ __forceinline__ void fft_inv(float (&re)[16], float (&im)[16], int tid, LAS f32x2* E1, LAS f32x2* E2, const f32x2* TW) {
  __syncthreads();
  const int h = tid & 1, q = (tid >> 5) + 16 * ((tid >> 1) & 15);
  dft16<true>(re, im);
#pragma unroll
  for (int s = 0; s < 16; ++s) { float tr = re[s], ti = im[s]; cmul<true>(tr, ti, W32C(s), -W32S(s)); if (h) { re[s] = tr; im[s] = ti; }
    const float pr = DPP_F(re[s], 0xB1), pi = DPP_F(im[s], 0xB1);
    re[s] = h ? pr - re[s] : re[s] + pr; im[s] = h ? pi - im[s] : im[s] + pi; }
  { const f32x2 bs = TW[(16 * h * q) & 8191], th = TW[q]; twchain<true>(re, im, bs.x, bs.y, th.x, th.y); }
#pragma unroll
  for (int s = 0; s < 16; ++s) E2[e2_r(tid, s)] = (f32x2){re[s], im[s]};
  __syncthreads();
#pragma unroll
  for (int s = 0; s < 16; ++s) { const f32x2 v = E2[e2_w(tid, s)]; re[s] = v.x; im[s] = v.y; }
  dft16<true>(re, im);
  { const f32x2 th = TW[32 * (tid >> 5)]; twchain<true>(re, im, 1.f, 0.f, th.x, th.y); }
#pragma unroll
  for (int s = 0; s < 16; ++s) E1[e1_r(tid, s)] = (f32x2){re[s], im[s]};
  __syncthreads();
#pragma unroll
  for (int s = 0; s < 16; ++s) { const f32x2 v = E1[e1_w(tid, s)]; re[s] = v.x; im[s] = v.y; }
  dft16<true>(re, im);
}
}

struct Args {
  const float* in[32]; float* out; unsigned char* ws; int ph_lo, ph_hi;
};
constexpr int LDS_BYTES = 163840;
constexpr int LDS_X = 131072;

__device__ __forceinline__ void wpow(const f32x2 w2, int j, float& wr, float& wi) { const float c = hf::W32C(j), s = -hf::W32S(j); wr = w2.x * c - w2.y * s; wi = w2.x * s + w2.y * c; }

#define GAS __attribute__((address_space(1)))
template <class T> __device__ __forceinline__ GAS T* opaque(T* p) { GAS T* g = (GAS T*)p; asm volatile("" : "+v"(g)); return g; }
#define PIN_MEM() do { asm volatile("" ::: "memory"); __builtin_amdgcn_sched_barrier(0); } while (0)
__device__ __forceinline__ void hy_conv(const float (&zr)[16], const float (&zi)[16], float (&yr)[16], float (&yi)[16], const f32x2* Ke, const f32x2* Ko, const f32x2 w2,
                                        int tid, LAS f32x2* E1, LAS f32x2* E2, const f32x2* TW) {
  float ar[16], ai[16];
#pragma unroll
  for (int j = 0; j < 16; ++j) { ar[j] = zr[j]; ai[j] = zi[j]; }
  PIN_MEM();
  hf::fft_fwd(ar, ai, tid, E1, E2, TW);
  PIN_MEM();
  const GAS f32x2* kep = opaque(Ke + tid);
#pragma unroll
  for (int j = 0; j < 16; ++j) { const f32x2 k = kep[j * 512]; const float r = ar[j] * k.x - ai[j] * k.y, i = ar[j] * k.y + ai[j] * k.x; ar[j] = r; ai[j] = i; }
  PIN_MEM();
  hf::fft_inv(ar, ai, tid, E1, E2, TW);
  PIN_MEM();
#pragma unroll
  for (int j = 0; j < 16; ++j) { yr[j] = ar[j]; yi[j] = ai[j]; }
  f32x2 w2a = w2; asm volatile("" : "+v"(w2a.x), "+v"(w2a.y));
#pragma unroll
  for (int j = 0; j < 16; ++j) { float wr, wi; wpow(w2a, j, wr, wi); ar[j] = zr[j] * wr - zi[j] * wi; ai[j] = zr[j] * wi + zi[j] * wr; }
  PIN_MEM();
  hf::fft_fwd(ar, ai, tid, E1, E2, TW);
  PIN_MEM();
  const GAS f32x2* kop = opaque(Ko + tid);
#pragma unroll
  for (int j = 0; j < 16; ++j) { const f32x2 k = kop[j * 512]; const float r = ar[j] * k.x - ai[j] * k.y, i = ar[j] * k.y + ai[j] * k.x; ar[j] = r; ai[j] = i; }
  PIN_MEM();
  hf::fft_inv(ar, ai, tid, E1, E2, TW);
  PIN_MEM();
  f32x2 w2b = w2; asm volatile("" : "+v"(w2b.x), "+v"(w2b.y));
#pragma unroll
  for (int j = 0; j < 16; ++j) { float wr, wi; wpow(w2b, j, wr, wi); const float br = ar[j] * wr + ai[j] * wi, bi = -ar[j] * wi + ai[j] * wr;
    yr[j] = (yr[j] + br) * (1.f / 16384.f); yi[j] = (yi[j] + bi) * (1.f / 16384.f); }
  PIN_MEM();
}
__device__ __forceinline__ void hy_load_stream(const bf16_t* HYT, int row, int b0, const float* cwp, const float* cbp, int tid, float (&xr)[16], float (&xi)[16]) {
  PIN_MEM();
  const float w0 = cwp[row], w1 = cwp[1536 + row], w2 = cwp[3072 + row], bb = cbp[row];
  const GAS bf16_t* p0 = opaque(HYT + (size_t)row * MTOK + (size_t)b0 * SEQ + tid); const GAS bf16_t* p1 = opaque(HYT + (size_t)row * MTOK + (size_t)(b0 + 1) * SEQ + tid);
#pragma unroll
  for (int j = 0; j < 16; ++j) { const int n = tid + 512 * j;
    const float a0 = bf2f(p0[512 * j]), a1 = bf2f(p1[512 * j]);
    float am0 = 0.f, am1 = 0.f, ap0 = 0.f, ap1 = 0.f;
    if (j > 0 || tid > 0) { am0 = bf2f(p0[512 * j - 1]); am1 = bf2f(p1[512 * j - 1]); }
    if (j < 15 || tid < 511) { ap0 = bf2f(p0[512 * j + 1]); ap1 = bf2f(p1[512 * j + 1]); }
    xr[j] = w0 * am0 + w1 * a0 + w2 * ap0 + bb; xi[j] = w0 * am1 + w1 * a1 + w2 * ap1 + bb;
    if ((j & 3) == 3) PIN_MEM(); }
  PIN_MEM();
}

__global__ void __launch_bounds__(NTHR, 2) fwd_mega(Args args) {
  __builtin_assume(__builtin_amdgcn_workitem_id_y() == 0); __builtin_assume(__builtin_amdgcn_workitem_id_z() == 0);
  extern __shared__ __attribute__((aligned(16))) unsigned char lds[];
  cg::grid_group grid = cg::this_grid();
  const int tid = threadIdx.x, lane = tid & 63, wave = __builtin_amdgcn_readfirstlane(tid >> 6);
  const int G = gridDim.x, bx = blockIdx.x;
  unsigned char* ws = args.ws;
  const float* x = args.in[0]; const float* cvec = args.in[1]; const float* ctx = args.in[2]; const float* c_ctx = args.in[3];
  const float* w_mod = args.in[4]; const float* b_mod = args.in[5]; const float* norm1_w = args.in[6]; const float* norm2_w = args.in[7];
  const float* w_in = args.in[8]; const float* b_in = args.in[9]; const float* q_norm_w = args.in[10]; const float* k_norm_w = args.in[11];
  const float* hy_conv_w = args.in[12]; const float* hy_conv_b = args.in[13]; const float* filt_w1 = args.in[14]; const float* filt_b1 = args.in[15];
  const float* filt_w_inner = args.in[16]; const float* filt_b_inner = args.in[17]; const float* filt_freq = args.in[18]; const float* filt_w_out = args.in[19];
  const float* hy_skip = args.in[20]; const float* w_attn_out = args.in[21]; const float* w_hy_out = args.in[22]; const float* w_o = args.in[23]; const float* b_o = args.in[24];
  const float* w_up = args.in[25]; const float* b_up = args.in[26]; const float* ffn_conv_w = args.in[27]; const float* ffn_conv_b = args.in[28];
  const float* w_down = args.in[29]; const float* b_down = args.in[30]; const float* final_norm_w = args.in[31];
  float* MODP = (float*)(ws + WS_MODP); float* MOD = (float*)(ws + WS_MOD);
  f32x2* TW = (f32x2*)(ws + WS_TW); f32x2* TW2 = (f32x2*)(ws + WS_TW2); f32x2* ROPE = (f32x2*)(ws + WS_ROPE); float* H3T = (float*)(ws + WS_H3T);
  bf16_t* WMAIN = (bf16_t*)(ws + WS_WMAIN); bf16_t* WHY = (bf16_t*)(ws + WS_WHY); bf16_t* WA = (bf16_t*)(ws + WS_WA); bf16_t* WH = (bf16_t*)(ws + WS_WH);
  bf16_t* WO = (bf16_t*)(ws + WS_WO); bf16_t* WUP = (bf16_t*)(ws + WS_WUP); bf16_t* WDN = (bf16_t*)(ws + WS_WDN);
  bf16_t* Qb = (bf16_t*)(ws + WS_Q); bf16_t* MIX = Qb; bf16_t* Kb = (bf16_t*)(ws + WS_K); bf16_t* Vb = (bf16_t*)(ws + WS_V);
  bf16_t* HYT = (bf16_t*)(ws + WS_HYT); bf16_t* H2 = HYT; bf16_t* SG = (bf16_t*)(ws + WS_SG); bf16_t* Fb = SG;
  bf16_t* Hb = (bf16_t*)(ws + WS_H); bf16_t* AO = Hb; bf16_t* HO = (bf16_t*)(ws + WS_HO);
  float* out = args.out;
  const int lo = args.ph_lo, hi = args.ph_hi;
#ifndef PHMASK
#define PHMASK 0x3ff
#endif
#define IN(k) (((PHMASK >> (k)) & 1) && lo <= (k) && (k) < hi)
#define SEAM(k) do { if (IN(k) && IN((k) + 1)) grid.sync(); } while (0)
  LAS unsigned char* ldsl = (LAS unsigned char*)lds;

  if (IN(0)) {
    { float* sl = (float*)lds;
      for (int it = bx; it < 192; it += G) { const int cgp = it % 12, ks = it / 12;
        __syncthreads();
        if (tid < 320) { const int r = tid >> 6, k = ks * 64 + (tid & 63); const float v = (r < 4) ? cvec[r * DM + k] : c_ctx[k]; sl[tid] = v / (1.f + __expf(-v)); }
        __syncthreads();
        const int col = cgp * 512 + tid; float a0 = 0, a1 = 0, a2 = 0, a3 = 0, a4 = 0;
#pragma unroll 8
        for (int k = 0; k < 64; ++k) { const float w = w_mod[(size_t)(ks * 64 + k) * NMOD + col]; a0 += sl[k] * w; a1 += sl[64 + k] * w; a2 += sl[128 + k] * w; a3 += sl[192 + k] * w; a4 += sl[256 + k] * w; }
        float* o = MODP + (size_t)ks * 5 * NMOD + col; o[0] = a0; o[NMOD] = a1; o[2 * NMOD] = a2; o[3 * NMOD] = a3; o[4 * NMOD] = a4; }
      __syncthreads(); }
    { LAS float* scr = (LAS float*)(ldsl + wave * 16384);
      constexpr int I0 = 16 * 160, I1 = 16 * 32, I2 = 8 * 32, I3 = 16 * 32, I4 = 16 * 176, I5 = 44 * 32, NIT = I0 + I1 + I2 + I3 + I4 + I5;
      for (int it = bx * NWAVE + wave; it < NIT; it += G * NWAVE) {
        int r = it; const float* W; int K, N; int mid;
        if (r < I0) { W = w_in; K = 1024; N = 5120; mid = 0; } else if ((r -= I0) < I1) { W = w_attn_out; K = 1024; N = 1024; mid = 1; } else if ((r -= I1) < I2) { W = w_hy_out; K = 512; N = 1024; mid = 2; }
        else if ((r -= I2) < I3) { W = w_o; K = 1024; N = 1024; mid = 3; } else if ((r -= I3) < I4) { W = w_up; K = 1024; N = 5632; mid = 4; } else { r -= I4; W = w_down; K = 2816; N = 1024; mid = 5; }
        const int nblk = N / 32, kb = r / nblk, nb = r % nblk, k0 = 64 * kb, n0 = 32 * nb;
        bf16_t* dst;
        if (mid == 0) dst = (n0 < 1536) ? WMAIN + (size_t)n0 * 1024 : (n0 < 3072) ? WHY + (size_t)(n0 - 1536) * 1024 : WMAIN + (size_t)(n0 - 1536) * 1024;
        else if (mid == 1) dst = WA + (size_t)n0 * 1024; else if (mid == 2) dst = WH + (size_t)n0 * 512; else if (mid == 3) dst = WO + (size_t)n0 * 1024;
        else if (mid == 4) { const int g = n0 >= DFF, idx = n0 - g * DFF; dst = WUP + (size_t)((idx >> 7) * 256 + g * 128 + (idx & 127)) * 1024; }
        else dst = WDN + (size_t)n0 * DFF;
#pragma unroll 8
        for (int i = 0; i < 32; ++i) { const int kk = 2 * i + (lane >> 5); scr[kk * 33 + (lane & 31)] = W[(size_t)(k0 + kk) * N + n0 + (lane & 31)]; }
        asm volatile("s_waitcnt lgkmcnt(0)" ::: "memory");
        const int c = lane & 7;
#pragma unroll
        for (int j = 0; j < 4; ++j) { const int n = (lane >> 3) + 8 * j; const LAS float* s = scr + (8 * c) * 33 + n;
          u32x4 o; o.x = cvt_pk_bf16(s[0 * 33], s[1 * 33]); o.y = cvt_pk_bf16(s[2 * 33], s[3 * 33]); o.z = cvt_pk_bf16(s[4 * 33], s[5 * 33]); o.w = cvt_pk_bf16(s[6 * 33], s[7 * 33]);
          *(u32x4*)(dst + (size_t)n * K + k0 + 8 * c) = o; }
        asm volatile("s_waitcnt lgkmcnt(0)" ::: "memory");
      }
      __syncthreads(); }
    { float* zf = (float*)lds; float* h1 = zf + 8 * 36; float* h2 = h1 + 8 * 64;
      for (int pb = bx; pb < 256; pb += G) {
        for (int rnd = 0; rnd < 4; ++rnd) { const int p0 = pb * 32 + rnd * 8;
          __syncthreads();
          if (tid < 8 * 33) { const int p = tid / 33, f = tid % 33, t = p0 + p; const float tf = (float)t; float v;
            if (f == 0) v = tf / 8191.0f;
            else { const int b = (f - 1) & 15; const float fb = 1e-4f + (float)b * ((15.0f - 1e-4f) / 15.0f); const float wp = 6.283185307179586f * tf / 8192.0f; const float a = wp * fb; v = (f <= 16) ? cosf(a) : -sinf(a); }
            zf[p * 36 + f] = v; }
          __syncthreads();
          const int p = tid >> 6, uu = tid & 63; const float fr_ = filt_freq[uu];
          { float a = filt_b1[uu];
#pragma unroll
            for (int i = 0; i < 33; ++i) a += zf[p * 36 + i] * filt_w1[i * 64 + uu];
            h1[p * 64 + uu] = sinf(fr_ * a); }
          __syncthreads();
          { float a = filt_b_inner[uu];
#pragma unroll 8
            for (int i = 0; i < 64; ++i) a += h1[p * 64 + i] * filt_w_inner[i * 64 + uu];
            h2[p * 64 + uu] = sinf(fr_ * a); }
          __syncthreads();
          { float a = filt_b_inner[64 + uu];
#pragma unroll 8
            for (int i = 0; i < 64; ++i) a += h2[p * 64 + i] * filt_w_inner[4096 + i * 64 + uu];
            H3T[(size_t)uu * SEQ + p0 + p] = sinf(fr_ * a); }
        }
      }
      __syncthreads(); }
    for (int i = bx * NTHR + tid; i < 8192 + 512 + 4096; i += G * NTHR) {
      if (i < 8192) { float s, c; sincospif((float)i * (1.0f / 4096.0f), &s, &c); TW[i] = (f32x2){c, -s}; }
      else if (i < 8192 + 512) { const int t = i - 8192; float s, c; sincospif((float)t * (1.0f / 8192.0f), &s, &c); TW2[t] = (f32x2){c, -s}; }
      else { const int j = i - 8704, pos = j >> 5, fi = j & 31; const float fq_ = powf(10000.0f, -(float)(2 * fi) / 64.0f); const float a = (float)pos * fq_; ROPE[j] = (f32x2){cosf(a), sinf(a)}; }
    }
  }
  SEAM(0);

  if (IN(1)) {
    float* modl = (float*)lds;
    for (int i = tid; i < 5 * 2048; i += NTHR) { const int r = i >> 11, cc = i & 2047; float s = b_mod[cc];
#pragma unroll
      for (int ks = 0; ks < 16; ++ks) s += MODP[(size_t)(ks * 5 + r) * NMOD + cc];
      modl[i] = s; }
    if (bx < 60) { const int i = bx * 512 + tid; const int r = i / NMOD, cc = i % NMOD; float s = b_mod[cc];
#pragma unroll
      for (int ks = 0; ks < 16; ++ks) s += MODP[(size_t)(ks * 5 + r) * NMOD + cc];
      MOD[i] = s; }
    __syncthreads();
    for (int m = bx * NWAVE + wave; m < MTOK; m += G * NWAVE) {
      const f32x4* xr = (const f32x4*)(x + (size_t)m * DM) + lane; const int b = m >> 13;
      f32x4 v[4]; float s = 0.f;
#pragma unroll
      for (int j = 0; j < 4; ++j) { v[j] = xr[64 * j]; s += (v[j].x * v[j].x + v[j].y * v[j].y) + (v[j].z * v[j].z + v[j].w * v[j].w); }
      const float rs = rsqrtf(wave_sum(s) * (1.f / DM) + RMS_EPS);
      unsigned long long* o8 = (unsigned long long*)(Hb + (size_t)m * DM) + lane;
#pragma unroll
      for (int j = 0; j < 4; ++j) { const int cc = 4 * lane + 256 * j; const f32x4 nw = *(const f32x4*)(norm1_w + cc), sh = *(const f32x4*)(modl + b * 2048 + cc), sc = *(const f32x4*)(modl + b * 2048 + 1024 + cc);
        const f32x4 h = v[j] * rs * nw * (sc + 1.f) + sh;
        o8[64 * j] = (unsigned long long)cvt_pk_bf16(h.x, h.y) | ((unsigned long long)cvt_pk_bf16(h.z, h.w) << 32); }
    }
    { bf16_t* At = (bf16_t*)(lds + 49152);
      float* red = (float*)(lds + 49152 + 16 * 1032 * 2);
      for (int it = bx; it < 256; it += G) { const int rb = it >> 2, hs = it & 3, cb = (hs < 2 ? 1024 : 1280) + (hs & 1) * 128;
        __syncthreads();
        for (int rr = 0; rr < 2; ++rr) { const int r = wave * 2 + rr; const f32x4* xr = (const f32x4*)(ctx + (size_t)(rb * 16 + r) * DM) + lane;
          f32x4 v[4]; float s = 0.f;
#pragma unroll
          for (int j = 0; j < 4; ++j) { v[j] = xr[64 * j]; s += (v[j].x * v[j].x + v[j].y * v[j].y) + (v[j].z * v[j].z + v[j].w * v[j].w); }
          const float rs = rsqrtf(wave_sum(s) * (1.f / DM) + RMS_EPS);
#pragma unroll
          for (int j = 0; j < 4; ++j) { const int cc = 4 * lane + 256 * j; const f32x4 nw = *(const f32x4*)(norm1_w + cc), sh = *(const f32x4*)(modl + 4 * 2048 + cc), sc = *(const f32x4*)(modl + 4 * 2048 + 1024 + cc);
            const f32x4 h = v[j] * rs * nw * (sc + 1.f) + sh;
            *(unsigned long long*)(At + r * 1032 + cc) = (unsigned long long)cvt_pk_bf16(h.x, h.y) | ((unsigned long long)cvt_pk_bf16(h.z, h.w) << 32); } }
        __syncthreads();
        f32x4 acc = {0.f, 0.f, 0.f, 0.f}; const int col = cb + wave * 16 + (lane & 15), kq = lane >> 4;
        for (int s = 0; s < 32; ++s) { const bf16x8 a = *(const bf16x8*)(At + (lane & 15) * 1032 + 32 * s + 8 * kq);
          const float* wp = w_in + (size_t)(32 * s + 8 * kq) * PW + col; u32x4 bw;
          bw.x = cvt_pk_bf16(wp[0], wp[PW]); bw.y = cvt_pk_bf16(wp[2 * PW], wp[3 * PW]); bw.z = cvt_pk_bf16(wp[4 * PW], wp[5 * PW]); bw.w = cvt_pk_bf16(wp[6 * PW], wp[7 * PW]);
          acc = __builtin_amdgcn_mfma_f32_16x16x32_bf16(a, __builtin_bit_cast(bf16x8, bw), acc, 0, 0, 0); }
        const float bs = b_in[col];
#pragma unroll
        for (int e = 0; e < 4; ++e) acc[e] += bs;
        const int grow0 = rb * 16, b = grow0 >> 8, t0 = grow0 & 255, hcol = (hs & 1) * 128 + wave * 16 + (lane & 15);
        if (hs < 2) {
          float ss[4];
#pragma unroll
          for (int e = 0; e < 4; ++e) { float s = acc[e] * acc[e]; s += __shfl_xor(s, 1); s += __shfl_xor(s, 2); s += __shfl_xor(s, 4); s += __shfl_xor(s, 8); ss[e] = s; }
          if ((lane & 15) == 0) {
#pragma unroll
            for (int e = 0; e < 4; ++e) red[wave * 16 + 4 * kq + e] = ss[e]; }
          __syncthreads();
          const float nw = k_norm_w[wave * 16 + (lane & 15)];
#pragma unroll
          for (int e = 0; e < 4; ++e) { const int r = 4 * kq + e; float tot = 0.f;
#pragma unroll
            for (int w8 = 0; w8 < 8; ++w8) tot += red[w8 * 16 + r];
            const float y = acc[e] * rsqrtf(tot * (1.f / 128.f) + RMS_EPS) * nw;
            Kb[((size_t)b * KVLEN + t0 + r) * 256 + hcol] = (bf16_t)f2bf(y); }
        } else {
#pragma unroll
          for (int e = 0; e < 4; ++e) { const int r = 4 * kq + e; Vb[((size_t)b * KVLEN + t0 + r) * 256 + hcol] = (bf16_t)f2bf(acc[e]); }
        }
      }
      __syncthreads(); }
  }
  SEAM(1);

  if (IN(2)) {
    { pg8::StaticOrder S; S.init(MTOK / 256, 14, G, bx);
      pg8::EpiInProj E{Qb, Kb, Vb, SG, b_in, q_norm_w, k_norm_w, ROPE, (LAS float*)(ldsl + LDS_X)};
      pg8::gemm_phase<pg8::EpiInProj, pg8::StaticOrder, pg8::AMapPlain, true, true>(ldsl, Hb, WMAIN, DM, S, E, pg8::AMapPlain{}); }
    { pg8::StaticOrder S; S.init(6, MTOK / 256, G, bx);
      pg8::EpiHy E{HYT, b_in};
      pg8::gemm_phase<pg8::EpiHy, pg8::StaticOrder, pg8::AMapPlain, true, true>(ldsl, WHY, Hb, DM, S, E, pg8::AMapPlain{}); }
  }
  SEAM(2);

  if (IN(3)) {
    LAS f32x2* E1 = (LAS f32x2*)ldsl; LAS f32x2* E2 = (LAS f32x2*)(ldsl + 65536);
    f32x2* KS = (f32x2*)((unsigned char*)out + (size_t)bx * KS_PER_WG);
    float* FS = (float*)((unsigned char*)out + 64 * MiB + (size_t)bx * (4 * SEQ * 4));
#ifndef NO_HYENA
    for (int c = bx; c < DHY; c += G) {
      int tc = threadIdx.x; asm volatile("" : "+v"(tc)); const f32x2 w2 = TW2[tc];
      __syncthreads();
#ifndef HY_NO1
      { float acc[4][16];
#pragma unroll
        for (int f = 0; f < 4; ++f)
#pragma unroll
          for (int e = 0; e < 16; ++e) acc[f][e] = 0.f;
        for (int j = 0; j < 64; ++j) { float w[4];
#pragma unroll
          for (int f = 0; f < 4; ++f) w[f] = filt_w_out[(size_t)j * 2048 + (f & 1) * 1024 + (f >> 1) * 512 + c];
#pragma unroll
          for (int jj = 0; jj < 4; ++jj) { const f32x4 h = *(const f32x4*)(H3T + (size_t)j * SEQ + 4 * tc + 2048 * jj);
#pragma unroll
            for (int f = 0; f < 4; ++f)
#pragma unroll
              for (int e = 0; e < 4; ++e) acc[f][jj * 4 + e] += h[e] * w[f]; } }
        const float adel = fabsf(-3.0701134573253945f + (float)c * ((-15.350567286626973f + 3.0701134573253945f) / 511.0f));
#pragma unroll
        for (int jj = 0; jj < 4; ++jj) { f32x4 dec;
#pragma unroll
          for (int e = 0; e < 4; ++e) { const int n = 4 * tc + 2048 * jj + e; dec[e] = expf(-((float)n * (1.0f / 8191.0f)) * adel); }
#pragma unroll
          for (int f = 0; f < 4; ++f) { f32x4 v = {acc[f][jj * 4], acc[f][jj * 4 + 1], acc[f][jj * 4 + 2], acc[f][jj * 4 + 3]}; *(f32x4*)(FS + (size_t)f * SEQ + 4 * tc + 2048 * jj) = v * dec; } } }
#endif
      __syncthreads();
#ifndef HY_NO2
#pragma unroll 1
      for (int o = 0; o < 2; ++o) {
        float ar[16], ai[16], br[16], bi[16];
        const GAS float* fsf = opaque(FS + (o * 2) * SEQ + tc); const GAS float* fsb = opaque(FS + (o * 2 + 1) * SEQ);
#pragma unroll
        for (int j = 0; j < 16; ++j) { const int n = tc + 512 * j; const float f = fsf[512 * j], b = fsb[(SEQ - n) & (SEQ - 1)];
          const float sum = f + b, dif = (n == 0) ? sum : f - b; float wr, wi; wpow(w2, j, wr, wi);
          ar[j] = sum; ai[j] = 0.f; br[j] = dif * wr; bi[j] = dif * wi; }
        hf::fft_fwd(ar, ai, tc, E1, E2, TW);
        { GAS f32x2* ksp = opaque(KS + (o * 2) * 8192 + tc);
#pragma unroll
          for (int j = 0; j < 16; ++j) ksp[j * 512] = (f32x2){ar[j], ai[j]}; }
        hf::fft_fwd(br, bi, tc, E1, E2, TW);
        { GAS f32x2* ksp = opaque(KS + (o * 2 + 1) * 8192 + tc);
#pragma unroll
          for (int j = 0; j < 16; ++j) ksp[j * 512] = (f32x2){br[j], bi[j]}; }
      }
#endif
#ifndef HY_NO3
      const float sk0 = hy_skip[c], sk1 = hy_skip[DHY + c];
#pragma unroll 1
      for (int bp = 0; bp < 2; ++bp) {
        asm volatile("" : "+v"(tc));
        float vr[16], vi[16], yr[16], yi[16], gr[16], gi[16];
        hy_load_stream(HYT, 1024 + c, 2 * bp, hy_conv_w, hy_conv_b, tc, vr, vi);
        hy_conv(vr, vi, yr, yi, KS, KS + 8192, w2, tc, E1, E2, TW);
        hy_load_stream(HYT, c, 2 * bp, hy_conv_w, hy_conv_b, tc, gr, gi);
#pragma unroll
        for (int j = 0; j < 16; ++j) { vr[j] = gr[j] * (yr[j] + sk0 * vr[j]); vi[j] = gi[j] * (yi[j] + sk0 * vi[j]); }
        hy_conv(vr, vi, yr, yi, KS + 2 * 8192, KS + 3 * 8192, w2, tc, E1, E2, TW);
        hy_load_stream(HYT, 512 + c, 2 * bp, hy_conv_w, hy_conv_b, tc, gr, gi);
#pragma unroll
        for (int j = 0; j < 16; ++j) { const float z0 = gr[j] * (yr[j] + sk1 * vr[j]), z1 = gi[j] * (yi[j] + sk1 * vi[j]);
          GAS bf16_t* hop = opaque(HO + ((size_t)(2 * bp) * SEQ + tc + 512 * j) * DHY + c);
          hop[0] = (bf16_t)f2bf(z0); hop[(size_t)SEQ * DHY] = (bf16_t)f2bf(z1); }
      }
#endif
    }
#endif
    __syncthreads();
#ifndef NO_ATTN
    for (int ui = bx; ui < NB * NHQ * (SEQ / 256); ui += G) { const int xl = ui & 7, rest = ui >> 3, b = xl >> 1, kvh = xl & 1, qb = rest & 31, h = kvh * 4 + (rest >> 5);
      const bf16_t* Qp = Qb + ((size_t)b * SEQ + qb * 256) * 1024 + h * 128; const bf16_t* Kp = Kb + (size_t)b * KVLEN * 256 + kvh * 128; const bf16_t* Vp = Vb + (size_t)b * KVLEN * 256 + kvh * 128;
      bf16_t* Op = AO + ((size_t)b * SEQ + qb * 256) * 1024 + h * 128;
      attn::attn_dense_body(Qp, Kp, Vp, Op, KVLEN, (char*)lds); }
#endif
  }
  SEAM(3);

  if (IN(4)) {
    { pg8::StaticOrder S; S.init(MTOK / 256, 4, G, bx); pg8::EpiMerge<0> E{MIX, SG};
      pg8::gemm_phase<pg8::EpiMerge<0>, pg8::StaticOrder, pg8::AMapPlain, true, true>(ldsl, AO, WA, 1024, S, E, pg8::AMapPlain{}); }
    asm volatile("s_waitcnt vmcnt(0)" ::: "memory");
    { pg8::StaticOrder S; S.init(MTOK / 256, 4, G, bx); pg8::EpiMerge<1> E{MIX, SG};
      pg8::gemm_phase<pg8::EpiMerge<1>, pg8::StaticOrder, pg8::AMapPlain, true, true>(ldsl, HO, WH, 512, S, E, pg8::AMapPlain{}); }
  }
  SEAM(4);
  if (IN(5)) {
    pg8::StaticOrder S; S.init(MTOK / 256, 4, G, bx); pg8::EpiGateRes E{x, out, b_o, MOD + 2048};
    pg8::gemm_phase<pg8::EpiGateRes, pg8::StaticOrder, pg8::AMapPlain, true, true>(ldsl, MIX, WO, 1024, S, E, pg8::AMapPlain{});
  }
  SEAM(5);
  if (IN(6)) {
    for (int m = bx * NWAVE + wave; m < MTOK; m += G * NWAVE) {
      const f32x4* xr = (const f32x4*)(out + (size_t)m * DM) + lane; const int b = m >> 13;
      f32x4 v[4]; float s = 0.f;
#pragma unroll
      for (int j = 0; j < 4; ++j) { v[j] = xr[64 * j]; s += (v[j].x * v[j].x + v[j].y * v[j].y) + (v[j].z * v[j].z + v[j].w * v[j].w); }
      const float rs = rsqrtf(wave_sum(s) * (1.f / DM) + RMS_EPS);
      unsigned long long* o8 = (unsigned long long*)(H2 + (size_t)(m + 1) * DM) + lane;
#pragma unroll
      for (int j = 0; j < 4; ++j) { const int cc = 4 * lane + 256 * j; const f32x4 nw = *(const f32x4*)(norm2_w + cc), sh = *(const f32x4*)(MOD + b * NMOD + 3072 + cc), sc = *(const f32x4*)(MOD + b * NMOD + 4096 + cc);
        const f32x4 h = v[j] * rs * nw * (sc + 1.f) + sh;
        o8[64 * j] = (unsigned long long)cvt_pk_bf16(h.x, h.y) | ((unsigned long long)cvt_pk_bf16(h.z, h.w) << 32); }
    }
    for (int i = bx * NTHR + tid; i < 256 * (DM / 8); i += G * NTHR) { const int r = i / (DM / 8), cc = (i % (DM / 8)) * 8; const size_t row = (r == 0) ? 0 : (size_t)MTOK + r;
      *(u32x4*)(H2 + row * DM + cc) = (u32x4){0u, 0u, 0u, 0u}; }
  }
  SEAM(6);
  if (IN(7)) {
    pg8::StaticOrder S; S.init(131, 22, G, bx); pg8::EpiUp E{Fb, b_up, ffn_conv_w, ffn_conv_b};
    pg8::gemm_phase<pg8::EpiUp, pg8::StaticOrder, pg8::AMapUp, true, true>(ldsl, H2, WUP, 1024, S, E, pg8::AMapUp{});
  }
  SEAM(7);
  if (IN(8)) {
    pg8::StaticOrder S; S.init(MTOK / 256, 4, G, bx); pg8::EpiGateRes E{out, out, b_down, MOD + 5120};
    pg8::gemm_phase<pg8::EpiGateRes, pg8::StaticOrder, pg8::AMapPlain, true, true>(ldsl, Fb, WDN, DFF, S, E, pg8::AMapPlain{});
  }
  SEAM(8);
  if (IN(9)) {
    for (int m = bx * NWAVE + wave; m < MTOK; m += G * NWAVE) {
      f32x4* xr = (f32x4*)(out + (size_t)m * DM) + lane;
      f32x4 v[4]; float s = 0.f;
#pragma unroll
      for (int j = 0; j < 4; ++j) { v[j] = xr[64 * j]; s += (v[j].x * v[j].x + v[j].y * v[j].y) + (v[j].z * v[j].z + v[j].w * v[j].w); }
      const float rs = rsqrtf(wave_sum(s) * (1.f / DM) + RMS_EPS);
#pragma unroll
      for (int j = 0; j < 4; ++j) { const f32x4 nw = *(const f32x4*)(final_norm_w + 4 * lane + 256 * j); xr[64 * j] = v[j] * rs * nw; }
    }
  }
#ifdef DBG_COPY
  if (lo <= 10 && 10 < hi) {
    const size_t n = (size_t)MTOK * DM;
    for (size_t i = (size_t)bx * NTHR + tid; i < n; i += (size_t)G * NTHR) { float v;
      if (DBG_COPY == 1) v = bf2f(Qb[i]);
      else if (DBG_COPY == 2) v = bf2f(AO[i]);
      else if (DBG_COPY == 3) v = bf2f(HO[i % ((size_t)MTOK * DHY)]);
      else if (DBG_COPY == 4) v = bf2f(Kb[i % ((size_t)NB * KVLEN * 256)]) + bf2f(Vb[i % ((size_t)NB * KVLEN * 256)]);
      else if (DBG_COPY == 5) v = bf2f(HYT[i]) + bf2f(SG[i]);
      else if (DBG_COPY == 6) v = bf2f(MIX[i]);
      else v = 0.f;
      out[i] = v; }
  }
#endif
#undef IN
#undef SEAM
}

extern "C" void kernel_launch(void* const* d_in, const int* in_sizes, int n_in, void* d_out, int out_size, void* d_ws, size_t ws_size, hipStream_t stream) {
  static int grid = 0;
  if (grid == 0) {
    if (n_in != 32 || in_sizes[0] != MTOK * DM || out_size != MTOK * DM || ws_size < WS_END) { fprintf(stderr, "kernel_launch: unexpected shapes (n_in %d, in0 %d, out %d, ws %zu)\n", n_in, n_in > 0 ? in_sizes[0] : -1, out_size, ws_size); grid = -1; return; }
    int dev = 0, cus = 0, per_cu = 0;
    (void)hipGetDevice(&dev); (void)hipDeviceGetAttribute(&cus, hipDeviceAttributeMultiprocessorCount, dev);
    if (hipFuncSetAttribute((const void*)fwd_mega, hipFuncAttributeMaxDynamicSharedMemorySize, LDS_BYTES) != hipSuccess) { fprintf(stderr, "kernel_launch: hipFuncSetAttribute failed\n"); grid = -1; return; }
    if (hipOccupancyMaxActiveBlocksPerMultiprocessor(&per_cu, (const void*)fwd_mega, NTHR, LDS_BYTES) != hipSuccess || per_cu < 1) { fprintf(stderr, "kernel_launch: occupancy query says %d\n", per_cu); per_cu = 1; }
    (void)hipGetLastError();
    grid = cus;
  }
  if (grid < 0) return;
  Args a{};
  for (int i = 0; i < 32; ++i) a.in[i] = (const float*)d_in[i];
  a.out = (float*)d_out; a.ws = (unsigned char*)d_ws;
#ifndef MK_LAUNCHES
#define MK_LAUNCHES 10
#endif
  if (MK_LAUNCHES == 1) {
    a.ph_lo = 0; a.ph_hi = 10; void* kargs[] = {&a};
    hipError_t e = hipLaunchCooperativeKernel((const void*)fwd_mega, dim3(grid), dim3(NTHR), kargs, LDS_BYTES, stream);
    if (e != hipSuccess) fprintf(stderr, "kernel_launch: cooperative launch failed: %s (grid %d)\n", hipGetErrorString(e), grid);
  } else {
#ifndef DBG_STOP
#define DBG_STOP 10
#endif
    for (int p = 0; p < 11; ++p) { if (p >= DBG_STOP && p != 10) continue;
#ifndef DBG_COPY
      if (p == 10) continue;
#endif
      a.ph_lo = p; a.ph_hi = p + 1; void* kargs[] = {&a};
      hipError_t e = hipLaunchCooperativeKernel((const void*)fwd_mega, dim3(grid), dim3(NTHR), kargs, LDS_BYTES, stream);
      if (e != hipSuccess) { fprintf(stderr, "kernel_launch: launch %d failed: %s\n", p, hipGetErrorString(e)); break; } }
  }
}
```
